# Optimizing an MI355X kernel written in HIP

```python
import math
import jax, jax.numpy as jnp
from jax import lax
import numpy as np

D_MODEL = 1024
BATCH = 8
SEQ = 4096
DEPTH = 4

GRID_W = 64
CTX_LEN = 256
N_EVEN = (DEPTH + 1) // 2
N_ODD = DEPTH // 2
S5_WIDTH = D_MODEL // 2
S5_GROUP = 16
S5_GROUPS = S5_WIDTH // S5_GROUP
S5_STATE = 64
NA_WIDTH = D_MODEL - S5_WIDTH
NA_HEAD_DIM = 64
NA_HEADS = NA_WIDTH // NA_HEAD_DIM
NA_WIN_R = 8
NA_WIN_C = 16
IN_WIDTH = S5_WIDTH + 3 * NA_WIDTH
MIX_WIDTH = S5_WIDTH + NA_WIDTH
D_FF = 4 * D_MODEL
N_MOD = 6
EPS = 1e-6
NEG_INF = -1e30

kernel_name = 'hybrid_s5_natten_fnet_dit_trunk'


def rms_norm(x, g):
    xf = x.astype(jnp.float32)
    y = xf * lax.rsqrt(jnp.mean(jnp.square(xf), axis=-1, keepdims=True) + EPS)
    return (y * g.astype(jnp.float32)).astype(x.dtype)


def modulate(x, shift, scale):
    return x * (1.0 + scale[:, None, :]) + shift[:, None, :]


def s5_discretise(lam_re, lam_im, log_dt, b_re, b_im):
    f32 = jnp.float32
    lam_re = jnp.minimum(lam_re.astype(f32), -1e-4)
    lam_im = lam_im.astype(f32)
    dt = jnp.exp(log_dt.astype(f32))[:, None]
    mag = jnp.exp(lam_re * dt)
    a_re = mag * jnp.cos(lam_im * dt)
    a_im = mag * jnp.sin(lam_im * dt)
    den = lam_re * lam_re + lam_im * lam_im
    num_re = a_re - 1.0
    f_re = (num_re * lam_re + a_im * lam_im) / den
    f_im = (a_im * lam_re - num_re * lam_im) / den
    b_re = b_re.astype(f32)
    b_im = b_im.astype(f32)
    bb_re = f_re[..., None] * b_re - f_im[..., None] * b_im
    bb_im = f_re[..., None] * b_im + f_im[..., None] * b_re
    return a_re, a_im, bb_re, bb_im


def _ssm_combine(left, right):
    a1r, a1i, b1r, b1i = left
    a2r, a2i, b2r, b2i = right
    ar = a2r * a1r - a2i * a1i
    ai = a2r * a1i + a2i * a1r
    br = a2r * b1r - a2i * b1i + b2r
    bi = a2r * b1i + a2i * b1r + b2i
    return ar, ai, br, bi


def s5_scan(u_tm, disc, s0):
    a_re, a_im, bb_re, bb_im = disc
    L = u_tm.shape[0]
    bu_re = jnp.einsum('lbgh,gph->lbgp', u_tm, bb_re)
    bu_im = jnp.einsum('lbgh,gph->lbgp', u_tm, bb_im)
    shape = (L, 1) + a_re.shape
    ar = jnp.broadcast_to(a_re, shape)
    ai = jnp.broadcast_to(a_im, shape)
    cum_re, cum_im, s_re, s_im = lax.associative_scan(_ssm_combine, (ar, ai, bu_re, bu_im), axis=0)
    if s0 is not None:
        s0_re, s0_im = s0
        s_re = s_re + cum_re * s0_re - cum_im * s0_im
        s_im = s_im + cum_re * s0_im + cum_im * s0_re
    return s_re, s_im


def s5_readout(s_re, s_im, c_re, c_im):
    return (jnp.einsum('lbgp,ghp->lbgh', s_re, c_re.astype(jnp.float32))
            - jnp.einsum('lbgp,ghp->lbgh', s_im, c_im.astype(jnp.float32)))


def s5_glu(y, w_glu):
    g = jax.nn.gelu(y)
    return g * jax.nn.sigmoid(g @ w_glu.astype(jnp.float32))


def s5_mixer(u_lat, u_ctx, lam_re, lam_im, log_dt, b_re, b_im, c_re, c_im, d_skip, w_glu, ctx_out):
    B, L, W = u_lat.shape
    Lc = u_ctx.shape[1]
    f32 = jnp.float32
    ul_f = u_lat.astype(f32)
    uc_f = u_ctx.astype(f32)
    ul = jnp.transpose(ul_f.reshape(B, L, S5_GROUPS, S5_GROUP), (1, 0, 2, 3))
    uc = jnp.transpose(uc_f.reshape(B, Lc, S5_GROUPS, S5_GROUP), (1, 0, 2, 3))
    d = d_skip.astype(f32)
    y_lat = d * ul_f
    y_ctx = d * uc_f if ctx_out else None
    for direction in range(2):
        rev = direction == 1
        disc = s5_discretise(lam_re[direction], lam_im[direction], log_dt[direction],
                             b_re[direction], b_im[direction])
        ucd = uc[::-1] if rev else uc
        uld = ul[::-1] if rev else ul
        sc_re, sc_im = s5_scan(ucd, disc, None)
        sl_re, sl_im = s5_scan(uld, disc, (sc_re[-1], sc_im[-1]))
        yl = s5_readout(sl_re, sl_im, c_re[direction], c_im[direction])
        yl = yl[::-1] if rev else yl
        y_lat = y_lat + jnp.transpose(yl, (1, 0, 2, 3)).reshape(B, L, W)
        if ctx_out:
            yc = s5_readout(sc_re, sc_im, c_re[direction], c_im[direction])
            yc = yc[::-1] if rev else yc
            y_ctx = y_ctx + jnp.transpose(yc, (1, 0, 2, 3)).reshape(B, Lc, W)
    out_lat = s5_glu(y_lat, w_glu).astype(u_lat.dtype)
    out_ctx = s5_glu(y_ctx, w_glu).astype(u_ctx.dtype) if ctx_out else None
    return out_lat, out_ctx


def na_mixer(q_l, k_l, v_l, q_c, k_c, v_c, rpb, ctx_out):
    f32 = jnp.float32
    B, L, NH, DH = q_l.shape
    rows = L // GRID_W
    win_r = min(NA_WIN_R, rows)
    win_c = NA_WIN_C
    scale = DH ** -0.5
    q_rows = jnp.arange(rows)
    r0 = jnp.clip(q_rows - win_r // 2, 0, rows - win_r)
    key_rows = r0[:, None] + jnp.arange(win_r)[None, :]
    cols = jnp.arange(GRID_W)
    c0 = jnp.clip(cols - win_c // 2, 0, GRID_W - win_c)
    col_ok = (cols[None, :] >= c0[:, None]) & (cols[None, :] < c0[:, None] + win_c)
    mask = jnp.broadcast_to(col_ok[:, None, :], (GRID_W, win_r, GRID_W)).reshape(GRID_W, win_r * GRID_W)
    dr = key_rows - q_rows[:, None] + (NA_WIN_R - 1)
    dc = jnp.clip(cols[None, :] - cols[:, None], -(win_c - 1), win_c - 1) + (win_c - 1)
    bias = rpb.astype(f32)[:, dr[:, None, :, None], dc[None, :, None, :]]
    bias = bias.reshape(NH, rows, GRID_W, win_r * GRID_W)
    qg = q_l.reshape(B, rows, GRID_W, NH, DH)
    k_blk = k_l.reshape(B, rows, GRID_W, NH, DH)[:, key_rows].reshape(B, rows, win_r * GRID_W, NH, DH)
    v_blk = v_l.reshape(B, rows, GRID_W, NH, DH)[:, key_rows].reshape(B, rows, win_r * GRID_W, NH, DH)
    s_lat = jnp.einsum('brqhd,brkhd->bhrqk', qg, k_blk).astype(f32) * scale + bias[None]
    s_lat = jnp.where(mask, s_lat, NEG_INF)
    s_ctx = jnp.einsum('brqhd,bkhd->bhrqk', qg, k_c).astype(f32) * scale
    p = jax.nn.softmax(jnp.concatenate([s_lat, s_ctx], axis=-1), axis=-1).astype(v_l.dtype)
    n_lat = win_r * GRID_W
    o = (jnp.einsum('bhrqk,brkhd->brqhd', p[..., :n_lat], v_blk)
         + jnp.einsum('bhrqk,bkhd->brqhd', p[..., n_lat:], v_c))
    out_lat = o.reshape(B, L, NH * DH)
    out_ctx = None
    if ctx_out:
        Lc = q_c.shape[1]
        s_cc = jnp.einsum('bqhd,bkhd->bhqk', q_c, k_c).astype(f32) * scale
        p_cc = jax.nn.softmax(s_cc, axis=-1).astype(v_c.dtype)
        out_ctx = jnp.einsum('bhqk,bkhd->bqhd', p_cc, v_c).reshape(B, Lc, NH * DH)
    return out_lat, out_ctx


def split_heads(z):
    B, L, _ = z.shape
    u = z[..., :S5_WIDTH]
    q, k, v = jnp.split(z[..., S5_WIDTH:], 3, axis=-1)
    shp = (B, L, NA_HEADS, NA_HEAD_DIM)
    return u, q.reshape(shp), k.reshape(shp), v.reshape(shp)


def even_mixer(hl, hc, w_in, w_out, lam_re, lam_im, log_dt, b_re, b_im, c_re, c_im, d_skip, w_glu, rpb, ctx_out):
    u_l, q_l, k_l, v_l = split_heads(hl @ w_in)
    u_c, q_c, k_c, v_c = split_heads(hc @ w_in)
    s5_l, s5_c = s5_mixer(u_l, u_c, lam_re, lam_im, log_dt, b_re, b_im, c_re, c_im, d_skip, w_glu, ctx_out)
    na_l, na_c = na_mixer(q_l, k_l, v_l, q_c, k_c, v_c, rpb, ctx_out)
    out_l = jnp.concatenate([s5_l, na_l], axis=-1) @ w_out
    out_c = jnp.concatenate([s5_c, na_c], axis=-1) @ w_out if ctx_out else None
    return out_l, out_c


def fourier_mix(h, w_f):
    hf = jnp.fft.fft2(h.astype(jnp.float32), axes=(1, 2), norm='ortho').real
    return hf.astype(h.dtype) @ w_f


def sqrelu_mlp(x, w1, w2):
    return jnp.square(jax.nn.relu(x @ w1)) @ w2


def setup_inputs(seed: int = 0) -> dict:
    key = jax.random.key(seed)
    ks = jax.random.split(key, 24)
    f32 = jnp.float32

    def nrm(k, shape, std):
        return jax.random.normal(k, shape, f32) * std

    G, P, H = S5_GROUPS, S5_STATE, S5_GROUP
    x = nrm(ks[0], (BATCH, SEQ, D_MODEL), 1.0)
    c = nrm(ks[1], (BATCH, D_MODEL), 1.0)
    ctx = nrm(ks[2], (BATCH, CTX_LEN, D_MODEL), 1.0)
    c_ctx = nrm(ks[3], (D_MODEL,), 1.0)
    w_mod = nrm(ks[4], (DEPTH, D_MODEL, N_MOD * D_MODEL), 0.5 * D_MODEL ** -0.5)
    b_mod = nrm(ks[5], (DEPTH, N_MOD * D_MODEL), 0.02)
    norm_g = 1.0 + nrm(ks[6], (DEPTH, 4, D_MODEL), 0.05)
    w_in = nrm(ks[7], (N_EVEN, D_MODEL, IN_WIDTH), D_MODEL ** -0.5)
    w_out_even = nrm(ks[8], (N_EVEN, MIX_WIDTH, D_MODEL), MIX_WIDTH ** -0.5)
    s5_lam_re = -0.5 + nrm(ks[9], (N_EVEN, 2, G, P), 0.01)
    s5_lam_im = math.pi * jnp.arange(P, dtype=f32) + nrm(ks[10], (N_EVEN, 2, G, P), 0.01)
    s5_log_dt = jax.random.uniform(ks[11], (N_EVEN, 2, G), f32, minval=math.log(1e-3), maxval=math.log(1e-1))
    s5_b_re = nrm(ks[12], (N_EVEN, 2, G, P, H), (2.0 * H) ** -0.5)
    s5_b_im = nrm(ks[13], (N_EVEN, 2, G, P, H), (2.0 * H) ** -0.5)
    s5_c_re = nrm(ks[14], (N_EVEN, 2, G, H, P), (2.0 * P) ** -0.5)
    s5_c_im = nrm(ks[15], (N_EVEN, 2, G, H, P), (2.0 * P) ** -0.5)
    s5_d = nrm(ks[16], (N_EVEN, S5_WIDTH), 1.0)
    s5_w_glu = nrm(ks[17], (N_EVEN, S5_WIDTH, S5_WIDTH), S5_WIDTH ** -0.5)
    na_rpb = nrm(ks[18], (N_EVEN, NA_HEADS, 2 * NA_WIN_R - 1, 2 * NA_WIN_C - 1), 0.1)
    w_fourier = nrm(ks[19], (N_ODD, D_MODEL, D_MODEL), D_MODEL ** -0.5)
    w_ff1 = nrm(ks[20], (DEPTH, D_MODEL, D_FF), D_MODEL ** -0.5)
    w_ff2 = nrm(ks[21], (DEPTH, D_FF, D_MODEL), D_FF ** -0.5)
    return {'x': x, 'c': c, 'ctx': ctx, 'c_ctx': c_ctx, 'w_mod': w_mod, 'b_mod': b_mod, 'norm_g': norm_g,
            'w_in': w_in, 'w_out_even': w_out_even, 's5_lam_re': s5_lam_re, 's5_lam_im': s5_lam_im,
            's5_log_dt': s5_log_dt, 's5_b_re': s5_b_re, 's5_b_im': s5_b_im, 's5_c_re': s5_c_re,
            's5_c_im': s5_c_im, 's5_d': s5_d, 's5_w_glu': s5_w_glu, 'na_rpb': na_rpb,
            'w_fourier': w_fourier, 'w_ff1': w_ff1, 'w_ff2': w_ff2}


def reference(x, c, ctx, c_ctx, w_mod, b_mod, norm_g, w_in, w_out_even, s5_lam_re, s5_lam_im, s5_log_dt,
              s5_b_re, s5_b_im, s5_c_re, s5_c_im, s5_d, s5_w_glu, na_rpb, w_fourier, w_ff1, w_ff2):
    last_ctx_layer = 2 * ((DEPTH - 1) // 2)
    h = x
    s = ctx
    c_act = jax.nn.silu(c)
    cc_act = jax.nn.silu(c_ctx)[None, :]
    for layer in range(DEPTH):
        need_ctx = layer <= last_ctx_layer
        upd_ctx = layer < last_ctx_layer
        mod_l = c_act @ w_mod[layer] + b_mod[layer]
        sh1, sc1, g1, sh2, sc2, g2 = jnp.split(mod_l, N_MOD, axis=-1)
        hl = modulate(rms_norm(h, norm_g[layer, 0]), sh1, sc1)
        hc = None
        if need_ctx:
            mod_c = cc_act @ w_mod[layer] + b_mod[layer]
            csh1, csc1, cg1, csh2, csc2, cg2 = jnp.split(mod_c, N_MOD, axis=-1)
            hc = modulate(rms_norm(s, norm_g[layer, 0]), csh1, csc1)
        if layer % 2 == 0:
            e = layer // 2
            out_l, out_c = even_mixer(hl, hc, w_in[e], w_out_even[e], s5_lam_re[e], s5_lam_im[e], s5_log_dt[e],
                                      s5_b_re[e], s5_b_im[e], s5_c_re[e], s5_c_im[e], s5_d[e], s5_w_glu[e],
                                      na_rpb[e], upd_ctx)
        else:
            o = layer // 2
            out_l = fourier_mix(hl, w_fourier[o])
            out_c = fourier_mix(hc, w_fourier[o]) if upd_ctx else None
        h = h + g1[:, None, :] * rms_norm(out_l, norm_g[layer, 1])
        hf = modulate(rms_norm(h, norm_g[layer, 2]), sh2, sc2)
        h = h + g2[:, None, :] * rms_norm(sqrelu_mlp(hf, w_ff1[layer], w_ff2[layer]), norm_g[layer, 3])
        if upd_ctx:
            s = s + cg1[:, None, :] * rms_norm(out_c, norm_g[layer, 1])
            sf = modulate(rms_norm(s, norm_g[layer, 2]), csh2, csc2)
            s = s + cg2[:, None, :] * rms_norm(sqrelu_mlp(sf, w_ff1[layer], w_ff2[layer]), norm_g[layer, 3])
    return h
```

```cpp
#include <hip/hip_runtime.h>
#include <hip/hip_cooperative_groups.h>
#include <cstdio>
namespace cg = cooperative_groups;

#ifndef N_LAUNCH_MODE
#define N_LAUNCH_MODE 1
#endif

#ifndef DUPMASK
#define DUPMASK 0
#endif
#define DUP(bit, stmt) do { _Pragma("nounroll") for (int _rep = 0; _rep < ((DUPMASK & (bit)) ? 2 : 1); ++_rep) { stmt; } } while (0)
#define LAS __attribute__((address_space(3)))
typedef unsigned short bf16_t;
typedef short bf16x8 __attribute__((ext_vector_type(8)));
typedef float f32x4 __attribute__((ext_vector_type(4)));
typedef float f32x2 __attribute__((ext_vector_type(2)));
typedef unsigned u32x4 __attribute__((ext_vector_type(4)));
typedef unsigned u32x2 __attribute__((ext_vector_type(2)));

constexpr int D = 1024, TL = 32768, TC = 2048, TT = 34816, DFF = 4096;
constexpr int NTHR = 512;
constexpr int LDS_STAGE = 131072;
constexpr int LDS_PARAM = LDS_STAGE + 64;
constexpr int LDS_BYTES = LDS_PARAM + 256;
constexpr size_t MiB = 1048576;
constexpr size_t WS_SCTX = 0, WS_MOD = 8 * MiB, WS_WIN = 9 * MiB, WS_WOUT = 17 * MiB, WS_WGLU = 21 * MiB, WS_WF = 22 * MiB,
                 WS_W1 = 26 * MiB, WS_W2 = 58 * MiB, WS_CDSD = 90 * MiB, WS_AL = 94 * MiB, WS_AL256 = 126 * MiB, WS_KTAB = 127 * MiB,
                 WS_BBAR = 135 * MiB, WS_ABUF = 136 * MiB, WS_BIG = 204 * MiB, WS_BAR = 476 * MiB, WS_PART = 477 * MiB, WS_END = 509 * MiB;
constexpr size_t BG_MG = 0, BG_WST = 80 * MiB, BG_U = 96 * MiB, BG_SLOC = 139 * MiB, BG_QKV = 156 * MiB, BG_G = BG_QKV, BG_R = BG_QKV + 34 * MiB;
constexpr size_t BO_ZA = 0, BO_YC = 128 * MiB, BO_PQC = 256 * MiB, BO_R = 0;
constexpr size_t WS_DA = WS_AL, WS_DC = WS_AL + 1 * MiB, WS_APOW = WS_AL + 2 * MiB;
constexpr int PQ_LD = 69632;
constexpr int UROWS = 544, ULD = 1280;

struct Params {
    const float* x; const float* c; const float* ctx; const float* c_ctx; const float* w_mod; const float* b_mod; const float* norm_g;
    const float* w_in; const float* w_out; const float* lam_re; const float* lam_im; const float* log_dt; const float* b_re; const float* b_im;
    const float* c_re; const float* c_im; const float* s5_d; const float* w_glu; const float* rpb; const float* w_f; const float* w_ff1; const float* w_ff2;
    float* out; unsigned char* ws;
};

__device__ __forceinline__ unsigned cvt_pk_bf16(float lo, float hi) { unsigned r; asm volatile("v_cvt_pk_bf16_f32 %0, %1, %2" : "=v"(r) : "v"(lo), "v"(hi)); return r; }
__device__ __forceinline__ bf16_t f2bf(float f) { return (bf16_t)(cvt_pk_bf16(f, 0.f) & 0xffffu); }
__device__ __forceinline__ float bf2f(unsigned short b) { return __uint_as_float(((unsigned)b) << 16); }
__device__ __forceinline__ float bflo(unsigned w) { return __uint_as_float(w << 16); }
__device__ __forceinline__ float bfhi(unsigned w) { return __uint_as_float(w & 0xffff0000u); }
__device__ __forceinline__ u32x4 pack8(f32x4 a, f32x4 b) { u32x4 r; r[0] = cvt_pk_bf16(a[0], a[1]); r[1] = cvt_pk_bf16(a[2], a[3]); r[2] = cvt_pk_bf16(b[0], b[1]); r[3] = cvt_pk_bf16(b[2], b[3]); return r; }
__device__ __forceinline__ int tid_opaque() { int t = threadIdx.x; asm volatile("" : "+v"(t)); return t; }
__device__ __forceinline__ float wave_sum(float v) { for (int o = 32; o > 0; o >>= 1) v += __shfl_xor(v, o); return v; }
__device__ __forceinline__ float gelu_tanh(float y) { const float z = 0.7978845608028654f * (y + 0.044715f * y * y * y); const float t = 1.f - 2.f / (__expf(2.f * z) + 1.f); return 0.5f * y * (1.f + t); }
__device__ __forceinline__ float sigmoidf(float v) { return 1.f / (1.f + __expf(-v)); }

__device__ __forceinline__ void apow(const Params& P, int e, int dir, int g, int p, float pw, float& ar, float& ai) {
    const int gi = (e * 2 + dir) * 32 + g, idx = gi * 64 + p;
    const float lr = fminf(P.lam_re[idx], -1e-4f), li = P.lam_im[idx], dt = expf(P.log_dt[gi]);
    const float mag = expf(lr * dt * pw);
    double rev = (double)li * (double)dt * (double)pw * 0.15915494309189535; rev -= floor(rev);
    const float ang = (float)rev * 6.283185307179586f;
    ar = mag * cosf(ang); ai = mag * sinf(ang);
}

constexpr int BM = 256, BK = 64, HALF = 128, HTB = HALF * BK * 2, NXCD = 8, WGM = 8;
__device__ __forceinline__ int lds_byte(int r, int c) { const int st = (r >> 4) * 2 + (c >> 5), rr = r & 15, cc = c & 31, ob = rr * 64 + cc * 2; return st * 1024 + (ob ^ (((ob >> 9) & 1) << 5)); }
__device__ __forceinline__ void stage_rc(int b, int& R, int& C) { const int st = b / 1024, sb = b % 1024, swz = sb ^ (((sb >> 9) & 1) << 5); R = (st >> 1) * 16 + swz / 64; C = (st & 1) * 32 + (swz % 64) / 2; }
__device__ __forceinline__ int perm32(int rho) { const int n = rho >> 4, i = rho & 15; return 8 * (i >> 2) + 4 * n + (i & 3); }

struct Unit { int pm, pn, pb; };
struct Gemm { const bf16_t* A; const bf16_t* Bt; long sA, sB; int lda, ldb, nM, nN, nB, K; int rev = 0; };
struct Order {
    int nM, nN, nwg, total, G, c, rev;
    __device__ void init(const Gemm& g, int G_, int c_) { nM = g.nM; nN = g.nN; nwg = nM * nN; total = nwg * g.nB; G = G_; c = c_; rev = g.rev; }
    __device__ bool next(int i, Unit& u) const {
        const long L = (long)i * G + c; if (L >= total) return false;
        const int pb = (int)(L / nwg); int wgid = (int)(L - (long)pb * nwg);
        { const int q = nwg / NXCD, r = nwg % NXCD, xcd = wgid % NXCD, off = wgid / NXCD; wgid = (xcd < r ? xcd * (q + 1) : r * (q + 1) + (xcd - r) * q) + off; }
        const int nig = WGM * nN, gid = wgid / nig, fm = gid * WGM, gsz = (nM - fm) < WGM ? (nM - fm) : WGM;
        u.pm = fm + ((wgid % nig) % gsz); u.pn = (wgid % nig) / gsz; u.pb = pb; if (rev) u.pm = nM - 1 - u.pm; return true;
    }
};

enum { M_PLAIN = 0, M_SQRELU, M_WIN, M_SLOC, M_YG, M_GLU, M_PQ, M_POS, M_POSC, M_PART, M_FA, M_FC };
template <int MODE> struct Epi {
    static constexpr int mode = MODE; int p0; void* o0; void* o1; const void* i0; float f0;
    __device__ __forceinline__ void store8(int pb, int row, int col0, f32x4 v0, f32x4 v1) const {
        switch (mode) {
        case M_PLAIN: { *(u32x4*)((bf16_t*)o0 + (size_t)row * p0 + col0) = pack8(v0, v1); } break;
        case M_SQRELU: {
#pragma unroll
            for (int i = 0; i < 4; ++i) { float a, b; asm("v_max_f32 %0, 0, %1" : "=v"(a) : "v"(v0[i])); asm("v_max_f32 %0, 0, %1" : "=v"(b) : "v"(v1[i])); v0[i] = a; v1[i] = b; }
            v0 *= v0; v1 *= v1;
            *(u32x4*)((bf16_t*)o0 + (size_t)row * p0 + col0) = pack8(v0, v1); } break;
        case M_WIN: {
            if (col0 < 512) { const int g = col0 >> 4, h0 = col0 & 15, r = row >> 6, j = row & 63;
                *(u32x4*)((bf16_t*)o0 + ((size_t)(g * UROWS + r) * ULD + j * 16 + h0)) = pack8(v0, v1); }
            else if (col0 < 1536) { if (col0 < 1024) { v0 *= 0.125f * 1.4426950408889634f; v1 *= 0.125f * 1.4426950408889634f; }
                *(u32x4*)((bf16_t*)o1 + (size_t)row * 1024 + (col0 - 512)) = pack8(v0, v1); }
            else { const u32x4 pk = pack8(v0, v1); bf16_t* vt = (bf16_t*)o1 + (size_t)TT * 1024 + (size_t)(col0 - 1536) * TT + row;
#pragma unroll
                for (int e = 0; e < 8; ++e) { const unsigned w = pk[e >> 1]; vt[(size_t)e * TT] = (bf16_t)((e & 1) ? (w >> 16) : (w & 0xffffu)); } } } break;
        case M_SLOC: { if (row < UROWS) { float* dst = (float*)o0 + ((size_t)(pb * UROWS + row) * 256 + col0); *(f32x4*)dst = v0; *(f32x4*)(dst + 4) = v1; } } break;
        case M_YG: { if (row < p0) { const int token = row < 512 ? row * 64 : TL + (row - 512) * 64; const int i = col0 >> 4, ho0 = col0 & 15;
#pragma unroll
                for (int k = 0; k < 4; ++k) { v0[k] = gelu_tanh(v0[k]); v1[k] = gelu_tanh(v1[k]); }
                *(u32x4*)((bf16_t*)o0 + (size_t)(token + i) * 512 + pb * 16 + ho0) = pack8(v0, v1); } } break;
        case M_GLU: { const u32x4 gv = *(const u32x4*)((const bf16_t*)i0 + (size_t)row * 512 + col0);
            v0[0] = bflo(gv[0]) * sigmoidf(v0[0]); v0[1] = bfhi(gv[0]) * sigmoidf(v0[1]); v0[2] = bflo(gv[1]) * sigmoidf(v0[2]); v0[3] = bfhi(gv[1]) * sigmoidf(v0[3]);
            v1[0] = bflo(gv[2]) * sigmoidf(v1[0]); v1[1] = bfhi(gv[2]) * sigmoidf(v1[1]); v1[2] = bflo(gv[3]) * sigmoidf(v1[2]); v1[3] = bfhi(gv[3]) * sigmoidf(v1[3]);
            *(u32x4*)((bf16_t*)o0 + (size_t)row * 1024 + col0) = pack8(v0, v1); } break;
        case M_PQ: {
            const bool isSin = row >= 513; const int m = isSin ? row - 512 : row; const int co = isSin ? 64 : 0;
            const u32x4 pk = pack8(v0, v1); const u32x4 npk = pack8(-v0, -v1); const u32x4 zz = {0u, 0u, 0u, 0u};
            if (col0 < TL) { bf16_t* ZA = (bf16_t*)o0; const int b = col0 >> 12, pi = col0 & 4095, t2 = pi >> 6, t1 = pi & 63, tp = t2 >> 1, j = t2 & 1;
                const size_t inner = (size_t)tp * 256 + j * 128 + co + t1;
                *(u32x4*)(ZA + (size_t)(b * 1024 + m) * 8192 + inner) = pk;
                if (m >= 1 && m <= 511) *(u32x4*)(ZA + (size_t)(b * 1024 + 1024 - m) * 8192 + inner) = isSin ? npk : pk;
                if (!isSin && (m == 0 || m == 512)) *(u32x4*)(ZA + (size_t)(b * 1024 + m) * 8192 + inner + 64) = zz; }
            else { bf16_t* PC = (bf16_t*)o1; const int tt = col0 - TL, b = tt >> 8, t = tt & 255; const size_t inner = (size_t)b * 512 + (isSin ? 256 : 0) + t;
                *(u32x4*)(PC + (size_t)m * 4096 + inner) = pk;
                if (m >= 1 && m <= 511) *(u32x4*)(PC + (size_t)(1024 - m) * 4096 + inner) = isSin ? npk : pk;
                if (!isSin && (m == 0 || m == 512)) *(u32x4*)(PC + (size_t)m * 4096 + inner + 256) = zz; } } break;
        case M_FC: { v0 *= f0; v1 *= f0; const int jj = row >> 6, k2 = row & 63, m0 = col0 & 1023, kq = (col0 >> 10) & 15, b = col0 >> 14; const int k = 4 * kq + jj + 64 * k2;
            *(u32x4*)((bf16_t*)o0 + ((size_t)(b * 4096 + k)) * 1024 + m0) = pack8(v0, v1); } break;
        case M_POSC: { v0 *= f0; v1 *= f0; *(u32x4*)((bf16_t*)o0 + ((size_t)(TL + pb * 256 + row)) * 1024 + col0) = pack8(v0, v1); } break;
        case M_PART: { float* dst = (float*)o0 + ((size_t)(pb * 2048 + row) * 1024 + col0); *(f32x4*)dst = v0; *(f32x4*)(dst + 4) = v1; } break;
        }
    }
    __device__ __forceinline__ void operator()(const f32x4 (&acc)[2][2][4][2], const Unit& u, int wr, int wc, int fr, int fq) const {
        asm volatile("" : "+v"(fr), "+v"(fq));
        if constexpr (MODE == M_FA) {
            bf16_t* YC = (bf16_t*)o0; const int j = wr;
#pragma unroll
            for (int m = 0; m < 4; ++m) { const int k1 = 16 * m + fr, kq = k1 >> 2, jj = k1 & 3;
#pragma unroll
                for (int bj = 0; bj < 2; ++bj) { const int col0 = u.pn * BM + bj * HALF + wc * 32 + 8 * fq; const int tp0 = col0 & 31, mch = (col0 >> 5) & 1023, b = col0 >> 15;
                    f32x4 r0, r1, i0, i1;
#pragma unroll
                    for (int e = 0; e < 8; ++e) { const float yr = e < 4 ? acc[0][bj][m][0][e & 3] : acc[0][bj][m][1][e & 3], yi = e < 4 ? acc[1][bj][m][0][e & 3] : acc[1][bj][m][1][e & 3];
                        const float ph = (float)(k1 * (2 * (tp0 + e) + j)) * (6.283185307179586f / 4096.f); const float cs = __cosf(ph), sn = __sinf(ph);
                        const float orr = yr * cs + yi * sn, oi = yi * cs - yr * sn;
                        if (e < 4) { r0[e & 3] = orr; i0[e & 3] = oi; } else { r1[e & 3] = orr; i1[e & 3] = oi; } }
                    bf16_t* dst = YC + ((size_t)((b * 16 + kq) * 1024 + mch)) * 512 + jj * 128 + j * 32 + tp0;
                    *(u32x4*)dst = pack8(r0, r1); *(u32x4*)(dst + 64) = pack8(i0, i1); __builtin_amdgcn_sched_barrier(0); } }
        } else {
#pragma unroll
        for (int ai = 0; ai < 2; ++ai)
#pragma unroll
            for (int m = 0; m < 4; ++m) { const int row = u.pm * BM + ai * HALF + wr * 64 + m * 16 + fr;
#pragma unroll
                for (int bj = 0; bj < 2; ++bj) { const int col0 = u.pn * BM + bj * HALF + wc * 32 + 8 * fq; store8(u.pb, row, col0, acc[ai][bj][m][0], acc[ai][bj][m][1]); } }
        }
    }
};

template <int MODE> __device__ __forceinline__ void gemm_phase(LAS unsigned char* lds, const Gemm g, const Epi<MODE>& E, int G, int bid) {
    Order S; S.init(g, G, bid);
    const int tid = tid_opaque(), wid = __builtin_amdgcn_readfirstlane(tid >> 6), lane = tid & 63, wr = wid >> 2, wc = wid & 3, fr = lane & 15, fq = lane >> 4;
    int K = g.K; asm volatile("" : "+s"(K));
    const int nt = K / BK;
    unsigned voffA[2], voffB[2];
#pragma unroll
    for (int i = 0; i < 2; ++i) { int R, C; stage_rc(tid * 16 + i * 8192, R, C); const int Rb = (R & ~31) + perm32(R & 31);
        voffA[i] = (unsigned)(R * g.lda + C) * 2u; voffB[i] = (unsigned)(Rb * g.ldb + C) * 2u; }
    const size_t kstep = (size_t)(BK * 2);
    const size_t hstepA = (size_t)HALF * g.lda * 2, hstepB = (size_t)HALF * g.ldb * 2;
    const size_t tstepA = 2 * hstepA, tstepB = 2 * hstepB;
    const unsigned ldsw = (unsigned)wid * 1024u;
    const int aoff = lds_byte(wr * 64 + fr, fq * 8), boff = lds_byte(wc * 32 + fr, fq * 8);
#define PG8_SA(b, h) (((b) * 2 + (h)) * HTB)
#define PG8_SB(b, h) ((4 + (b) * 2 + (h)) * HTB)
#define PG8_STAGE(bufoff, gbase, voff) do { _Pragma("unroll") for (int _i = 0; _i < 2; ++_i) \
        __builtin_amdgcn_global_load_lds((const unsigned*)((const char*)(gbase) + (voff)[_i]), (LAS unsigned*)(lds + (bufoff) + ldsw + _i * 8192), 16, 0, 0); } while (0)
#define PG8_LDA(dst, b, h) do { _Pragma("unroll") for (int m = 0; m < 4; ++m) _Pragma("unroll") for (int k = 0; k < 2; ++k) dst[m][k] = *(const LAS bf16x8*)(lds + PG8_SA(b, h) + aoff + m * 2048 + k * 1024); } while (0)
#define PG8_LDB(dst, b, h) do { _Pragma("unroll") for (int n = 0; n < 2; ++n) _Pragma("unroll") for (int k = 0; k < 2; ++k) dst[n][k] = *(const LAS bf16x8*)(lds + PG8_SB(b, h) + boff + n * 2048 + k * 1024); } while (0)
#define PG8_MMA(ai, bj, At, Bt) do { __builtin_amdgcn_s_setprio(1); _Pragma("unroll") for (int m = 0; m < 4; ++m) _Pragma("unroll") for (int n = 0; n < 2; ++n) _Pragma("unroll") for (int k = 0; k < 2; ++k) \
        acc[ai][bj][m][n] = __builtin_amdgcn_mfma_f32_16x16x32_bf16(Bt[n][k], At[m][k], acc[ai][bj][m][n], 0, 0, 0); __builtin_amdgcn_s_setprio(0); } while (0)
#define PG8_WAIT_V(n) asm volatile("s_waitcnt vmcnt(" #n ")" ::: "memory")
#define PG8_WAIT_L(n) asm volatile("s_waitcnt lgkmcnt(" #n ")" ::: "memory")
#define PG8_BAR __builtin_amdgcn_s_barrier()
#define PG8_SCHED __builtin_amdgcn_sched_barrier(0)
    Unit cur, nxt; int ui = 0;
    if (!S.next(0, cur)) return;
    f32x4 acc[2][2][4][2];
#pragma unroll
    for (int a = 0; a < 2; ++a)
#pragma unroll
        for (int b = 0; b < 2; ++b)
#pragma unroll
            for (int m = 0; m < 4; ++m)
#pragma unroll
                for (int n = 0; n < 2; ++n) acc[a][b][m][n] = (f32x4){0.f, 0.f, 0.f, 0.f};
    bf16x8 At[4][2], B0[2][2], B1[2][2];
    const char* cA = (const char*)g.A + (size_t)cur.pb * g.sA * 2 + (size_t)cur.pm * tstepA;
    const char* cB = (const char*)g.Bt + (size_t)cur.pb * g.sB * 2 + (size_t)cur.pn * tstepB;
    PG8_STAGE(PG8_SB(0, 0), cB, voffB); PG8_STAGE(PG8_SB(0, 1), cB + hstepB, voffB); PG8_STAGE(PG8_SA(0, 0), cA, voffA); PG8_STAGE(PG8_SA(0, 1), cA + hstepA, voffA);
    if (wr == 1) PG8_BAR;
    PG8_WAIT_V(2); PG8_BAR;
    PG8_STAGE(PG8_SB(1, 0), cB + kstep, voffB); PG8_STAGE(PG8_SA(1, 0), cA + kstep, voffA); PG8_STAGE(PG8_SB(1, 1), cB + hstepB + kstep, voffB);
    PG8_WAIT_V(6); PG8_BAR;
    for (;;) {
        const bool has_next = S.next(ui + 1, nxt);
        const char* nA = has_next ? (const char*)g.A + (size_t)nxt.pb * g.sA * 2 + (size_t)nxt.pm * tstepA : cA;
        const char* nB = has_next ? (const char*)g.Bt + (size_t)nxt.pb * g.sB * 2 + (size_t)nxt.pn * tstepB : cB;
        for (int t = 0; t < nt; t += 2) {
            const bool last = (t == nt - 2);
            const char* a1 = cA + (size_t)(t + 1) * kstep;
            const char* a2 = last ? nA : cA + (size_t)(t + 2) * kstep; const char* b2 = last ? nB : cB + (size_t)(t + 2) * kstep;
            const char* a3 = a2 + kstep; const char* b3 = b2 + kstep;
            PG8_LDB(B0, 0, 0); PG8_LDB(B1, 0, 1); PG8_SCHED; PG8_LDA(At, 0, 0); PG8_STAGE(PG8_SA(1, 1), a1 + hstepA, voffA);
            PG8_WAIT_V(8); PG8_WAIT_L(0); PG8_BAR; PG8_MMA(0, 0, At, B0); PG8_MMA(0, 1, At, B1); PG8_BAR; PG8_SCHED;
            PG8_LDA(At, 0, 1); PG8_STAGE(PG8_SB(0, 0), b2, voffB); PG8_STAGE(PG8_SB(0, 1), b2 + hstepB, voffB); PG8_STAGE(PG8_SA(0, 0), a2, voffA);
            PG8_WAIT_V(8); PG8_WAIT_L(0); PG8_BAR; PG8_MMA(1, 0, At, B0); PG8_MMA(1, 1, At, B1); PG8_BAR; PG8_SCHED;
            PG8_LDB(B0, 1, 0); PG8_LDB(B1, 1, 1); PG8_SCHED; PG8_LDA(At, 1, 0); PG8_STAGE(PG8_SA(0, 1), a2 + hstepA, voffA);
            PG8_WAIT_V(8); PG8_WAIT_L(0); PG8_BAR; PG8_MMA(0, 0, At, B0); PG8_MMA(0, 1, At, B1); PG8_BAR; PG8_SCHED;
            PG8_LDA(At, 1, 1); PG8_STAGE(PG8_SB(1, 0), b3, voffB); PG8_STAGE(PG8_SB(1, 1), b3 + hstepB, voffB); PG8_STAGE(PG8_SA(1, 0), a3, voffA);
            PG8_WAIT_V(8); PG8_WAIT_L(0); PG8_BAR; PG8_MMA(1, 0, At, B0); PG8_MMA(1, 1, At, B1); PG8_BAR; PG8_SCHED;
        }
        if (wr == 0) PG8_BAR;
        E(acc, cur, wr, wc, fr, fq);
        if (!has_next) break;
#pragma unroll
        for (int a = 0; a < 2; ++a)
#pragma unroll
            for (int b = 0; b < 2; ++b)
#pragma unroll
                for (int m = 0; m < 4; ++m)
#pragma unroll
                    for (int n = 0; n < 2; ++n) acc[a][b][m][n] = (f32x4){0.f, 0.f, 0.f, 0.f};
        cur = nxt; cA = nA; cB = nB; ++ui;
        if (wr == 1) PG8_BAR;
    }
    PG8_WAIT_V(0);
    PG8_BAR;
#undef PG8_SA
#undef PG8_SB
#undef PG8_STAGE
#undef PG8_LDA
#undef PG8_LDB
#undef PG8_MMA
#undef PG8_WAIT_V
#undef PG8_WAIT_L
#undef PG8_BAR
#undef PG8_SCHED
}

struct TJob { const float* W; bf16_t* WT; int K, N, t; };
__device__ __forceinline__ void tjob_load(const TJob& j, int tid, f32x4 (&va)[4], f32x4 (&vb)[4]) {
    const int ntn = j.N / 64, kp = tid >> 4, n0 = (tid & 15) * 4;
#pragma unroll
    for (int q = 0; q < 4; ++q) { const int tile = j.t + q, tk = tile / ntn, tn = tile % ntn; const float* src = j.W + (size_t)(tk * 64 + 2 * kp) * j.N + tn * 64 + n0; va[q] = __builtin_nontemporal_load((const f32x4*)src); vb[q] = __builtin_nontemporal_load((const f32x4*)(src + j.N)); }
}
__device__ __forceinline__ void tjob_store(LAS unsigned char* lds, const TJob& j, int tid, const f32x4 (&va)[4], const f32x4 (&vb)[4]) {
    const int ntn = j.N / 64; LAS unsigned* t32 = (LAS unsigned*)lds;
    { const int kp = tid >> 4, n0 = (tid & 15) * 4;
#pragma unroll
      for (int q = 0; q < 4; ++q)
#pragma unroll
          for (int i = 0; i < 4; ++i) t32[q * 64 * 33 + (n0 + i) * 33 + kp] = cvt_pk_bf16(va[q][i], vb[q][i]); }
    __syncthreads();
    { const int n = tid >> 3, k0 = (tid & 7) * 8;
#pragma unroll
      for (int q = 0; q < 4; ++q) { const int tile = j.t + q, tk = tile / ntn, tn = tile % ntn; const LAS unsigned* r = t32 + q * 64 * 33 + n * 33 + (k0 >> 1);
          u32x4 v; v[0] = r[0]; v[1] = r[1]; v[2] = r[2]; v[3] = r[3];
          *(u32x4*)(j.WT + (size_t)(tn * 64 + n) * j.K + tk * 64 + k0) = v; } }
    __syncthreads();
}

constexpr int MOD_SC_OFF = 65536, MOD_RED_OFF = MOD_SC_OFF + 9 * 1024 * 4;
__device__ __forceinline__ void mod_stage(const Params& P, LAS unsigned char* lds) {
    const int tid = tid_opaque(); LAS float* sc = (LAS float*)(lds + MOD_SC_OFF);
    float v[18];
#pragma unroll
    for (int j = 0; j < 18; ++j) { const int i = tid + NTHR * j, bi = i >> 10, k = i & 1023; v[j] = bi < 8 ? P.c[bi * 1024 + k] : P.c_ctx[k]; }
#pragma unroll
    for (int j = 0; j < 18; ++j) sc[tid + NTHR * j] = v[j] * __builtin_amdgcn_rcpf(1.f + __expf(-v[j]));
    __syncthreads();
}
__device__ __forceinline__ void mod_unit(const Params& P, LAS unsigned char* lds, float* MOD, int u) {
    const int tid = tid_opaque(); const int L = u / 192, n0 = (u % 192) * 32;
    LAS float* sc = (LAS float*)(lds + MOD_SC_OFF);
    LAS float* red = (LAS float*)(lds + MOD_RED_OFF);
    const int col = tid & 31, kp = tid >> 5;
    float acc[9];
#pragma unroll
    for (int b = 0; b < 9; ++b) acc[b] = 0.f;
    const float* w = P.w_mod + (size_t)L * 1024 * 6144 + (size_t)(kp * 64) * 6144 + n0 + col;
#pragma unroll
    for (int h = 0; h < 2; ++h) { float wv[32];
#pragma unroll
        for (int j = 0; j < 32; ++j) wv[j] = __builtin_nontemporal_load(w + (size_t)(h * 32 + j) * 6144);
#pragma unroll
        for (int j = 0; j < 32; ++j) { const int k = kp * 64 + h * 32 + j;
#pragma unroll
            for (int b = 0; b < 9; ++b) acc[b] += sc[b * 1024 + k] * wv[j]; } }
#pragma unroll
    for (int b = 0; b < 9; ++b) red[(kp * 9 + b) * 32 + col] = acc[b];
    __syncthreads();
    if (tid < 288) { const int b = tid >> 5, cc = tid & 31; float sm = P.b_mod[L * 6144 + n0 + cc];
#pragma unroll
        for (int q = 0; q < 16; ++q) sm += red[(q * 9 + b) * 32 + cc];
        MOD[(size_t)(L * 9 + b) * 6144 + n0 + cc] = sm; }
    __syncthreads();
}

__device__ __forceinline__ void ktab_unit(const Params& P, LAS unsigned char* lds, float* KTAB, float* BBAR, float* APOW, int u) {
    const int tid = tid_opaque(); const int half = u & 1, gi = u >> 1, g = gi & 31, dir = (gi >> 5) & 1, e = gi >> 6;
    LAS float* ap = (LAS float*)lds;
    LAS float* Cm = ap + 33 * 128;
    LAS float* Bb = Cm + 2048;
    const int nl = half ? 33 : 32;
    for (int i = tid; i < nl * 64; i += NTHR) { const int ll = i >> 6, p = i & 63, l = 32 * half + ll; float ar, ai; apow(P, e, dir, g, p, (float)l, ar, ai); ap[2 * i] = ar; ap[2 * i + 1] = ai;
        APOW[((size_t)(gi * 65 + l) * 64 + p) * 2] = ar; APOW[((size_t)(gi * 65 + l) * 64 + p) * 2 + 1] = ai; }
    for (int i = tid; i < 1024; i += NTHR) { const int ho = i >> 6, p = i & 63; Cm[2 * i] = P.c_re[(size_t)(gi * 16 + ho) * 64 + p]; Cm[2 * i + 1] = P.c_im[(size_t)(gi * 16 + ho) * 64 + p]; }
    for (int i = tid; i < 1024; i += NTHR) { const int p = i >> 4, hi = i & 15; float ar, ai; apow(P, e, dir, g, p, 1.f, ar, ai);
        const float lr = fminf(P.lam_re[gi * 64 + p], -1e-4f), li = P.lam_im[gi * 64 + p], den = lr * lr + li * li, nr = ar - 1.f;
        const float fre = (nr * lr + ai * li) / den, fim = (ai * lr - nr * li) / den;
        const float br = P.b_re[(size_t)(gi * 64 + p) * 16 + hi], bi = P.b_im[(size_t)(gi * 64 + p) * 16 + hi];
        const float bbr = fre * br - fim * bi, bbi = fre * bi + fim * br;
        Bb[2 * i] = bbr; Bb[2 * i + 1] = bbi; if (half == 0) { BBAR[((size_t)gi * 1024 + i) * 2] = bbr; BBAR[((size_t)gi * 1024 + i) * 2 + 1] = bbi; } }
    __syncthreads();
    { const int ll = tid >> 4, ho = tid & 15, l = 32 * half + ll; float acc[16];
#pragma unroll
      for (int hi = 0; hi < 16; ++hi) acc[hi] = 0.f;
      for (int p = 0; p < 64; ++p) { const f32x2 cc = *(const LAS f32x2*)(Cm + (ho * 64 + p) * 2), aa = *(const LAS f32x2*)(ap + (ll * 64 + p) * 2);
          const float wr = cc[0] * aa[0] - cc[1] * aa[1], wi = cc[0] * aa[1] + cc[1] * aa[0];
#pragma unroll
          for (int h4 = 0; h4 < 8; ++h4) { const f32x4 bb = *(const LAS f32x4*)(Bb + p * 32 + h4 * 4); acc[2 * h4] += wr * bb[0] - wi * bb[1]; acc[2 * h4 + 1] += wr * bb[2] - wi * bb[3]; } }
      float* dst = KTAB + ((size_t)(gi * 64 + l)) * 256 + ho * 16;
#pragma unroll
      for (int h4 = 0; h4 < 4; ++h4) *(f32x4*)(dst + 4 * h4) = (f32x4){acc[4 * h4], acc[4 * h4 + 1], acc[4 * h4 + 2], acc[4 * h4 + 3]}; }
    __syncthreads();
}

__device__ __forceinline__ void phase0(const Params& P, LAS unsigned char* lds, int G, int bid) {
    unsigned char* ws = P.ws; const int tid = tid_opaque();
    const int NT_TOTAL = 2 * 512 + 2 * 256 + 2 * 64 + 2 * 256 + 4 * 1024 + 4 * 1024;
#define TJOB_DECODE(j, u4_) do { int t = (u4_) * 4; \
        if (t < 1024) { const int e = t / 512; t %= 512; j.W = P.w_in + (size_t)e * 1024 * 2048; j.WT = (bf16_t*)(ws + WS_WIN) + (size_t)e * 2048 * 1024; j.K = 1024; j.N = 2048; } \
        else if ((t -= 1024) < 512) { const int e = t / 256; t %= 256; j.W = P.w_out + (size_t)e * 1024 * 1024; j.WT = (bf16_t*)(ws + WS_WOUT) + (size_t)e * 1024 * 1024; j.K = 1024; j.N = 1024; } \
        else if ((t -= 512) < 128) { const int e = t / 64; t %= 64; j.W = P.w_glu + (size_t)e * 512 * 512; j.WT = (bf16_t*)(ws + WS_WGLU) + (size_t)e * 512 * 512; j.K = 512; j.N = 512; } \
        else if ((t -= 128) < 512) { const int e = t / 256; t %= 256; j.W = P.w_f + (size_t)e * 1024 * 1024; j.WT = (bf16_t*)(ws + WS_WF) + (size_t)e * 1024 * 1024; j.K = 1024; j.N = 1024; } \
        else if ((t -= 512) < 4096) { const int e = t / 1024; t %= 1024; j.W = P.w_ff1 + (size_t)e * 1024 * 4096; j.WT = (bf16_t*)P.out + (size_t)e * 4096 * 1024; j.K = 1024; j.N = 4096; } \
        else { t -= 4096; const int e = t / 1024; t %= 1024; j.W = P.w_ff2 + (size_t)e * 4096 * 1024; j.WT = (bf16_t*)P.out + (size_t)4 * 4096 * 1024 + (size_t)e * 1024 * 4096; j.K = 4096; j.N = 1024; } \
        j.t = t; } while (0)
    { f32x4 va[4], vb[4]; TJob cur; cur.W = nullptr; cur.WT = nullptr; cur.K = 0; cur.N = 64; cur.t = 0;
      int u4 = bid;
      if (u4 < NT_TOTAL / 4) { TJOB_DECODE(cur, u4); tjob_load(cur, tid, va, vb); }
      while (u4 < NT_TOTAL / 4) {
          f32x4 wa[4], wb[4];
#pragma unroll
          for (int q = 0; q < 4; ++q) { wa[q] = va[q]; wb[q] = vb[q]; }
          const TJob now = cur; const int nu = u4 + G;
          if (nu < NT_TOTAL / 4) { TJOB_DECODE(cur, nu); tjob_load(cur, tid, va, vb); }
          tjob_store(lds, now, tid, wa, wb);
          u4 = nu;
      } }
#undef TJOB_DECODE
    mod_stage(P, lds);
    for (int u = bid; u < 768; u += G) mod_unit(P, lds, (float*)(ws + WS_MOD), u);
    for (int u = bid; u < 256; u += G) ktab_unit(P, lds, (float*)(ws + WS_KTAB), (float*)(ws + WS_BBAR), (float*)(ws + WS_APOW), u);
    const size_t gtid = (size_t)bid * NTHR + tid, gn = (size_t)G * NTHR;
    { bf16_t* T = (bf16_t*)(ws + WS_CDSD);
      for (size_t i = gtid; i < (size_t)1024 * 1024 / 2; i += gn) { const int row = (int)(i >> 9), d0 = (int)(i & 511) * 2; const bool isSin = row >= 513; const int m = isSin ? row - 512 : row; float v[2];
#pragma unroll
          for (int j = 0; j < 2; ++j) { const float ang = (float)((m * (d0 + j)) & 1023) * (6.283185307179586f / 1024.f); v[j] = isSin ? sinf(ang) : cosf(ang); }
          *(unsigned*)(T + (size_t)row * 1024 + d0) = cvt_pk_bf16(v[0], v[1]); } }
    { bf16_t* T = (bf16_t*)(ws + WS_DA);
      for (size_t i = gtid; i < (size_t)256 * 256; i += gn) { const int row = (int)(i >> 8), col = (int)(i & 255); const int c = row >> 7, j = (row >> 6) & 1, k1 = row & 63, j2 = col >> 7, c2 = (col >> 6) & 1, t1 = col & 63;
          const float ang = (float)((k1 * t1) & 63) * (6.283185307179586f / 64.f); float v = 0.f;
          if (j == j2) v = (c == 0) ? (c2 == 0 ? cosf(ang) : -sinf(ang)) : (c2 == 0 ? -sinf(ang) : -cosf(ang));
          T[i] = f2bf(v); } }
    { bf16_t* T = (bf16_t*)(ws + WS_DC);
      for (size_t i = gtid; i < (size_t)256 * 512; i += gn) { const int row = (int)(i >> 9), col = (int)(i & 511); const int jj = row >> 6, k2 = row & 63, jj2 = col >> 7, c = (col >> 6) & 1, j = (col >> 5) & 1, tp = col & 31, t2 = 2 * tp + j;
          const float ang = (float)((k2 * t2) & 63) * (6.283185307179586f / 64.f); float v = 0.f;
          if (jj == jj2) v = c == 0 ? cosf(ang) : sinf(ang);
          T[i] = f2bf(v); } }
    { bf16_t* T = (bf16_t*)(ws + WS_AL256);
      for (size_t i = gtid; i < (size_t)256 * 512 / 2; i += gn) { const int k = (int)(i >> 8), c0 = (int)(i & 255) * 2; float v[2];
#pragma unroll
          for (int j = 0; j < 2; ++j) { const int cc = c0 + j, t = cc & 255; const float ang = (float)((k * t) & 255) * (6.283185307179586f / 256.f); v[j] = cc < 256 ? cosf(ang) : -sinf(ang); }
          *(unsigned*)(T + (size_t)k * 512 + c0) = cvt_pk_bf16(v[0], v[1]); } }
}

struct RowArgs {
    const float* hin_lat; const float* hin_ctx; float* hout_lat; float* hout_ctx;
    const bf16_t* R; const float* modA; int gate_off; const float* gainA;
    bf16_t* A; const float* modB; int shift_off, scale_off; const float* gainB;
    int nrows; int perm; const float* part; const bf16_t* hin_bf; bf16_t* hout_bf;
};
template <int RP, bool HINBF, bool HOUTBF> __device__ __forceinline__ void rows_seq(const RowArgs& a, int row0, int n, int bi, int lane) {
    const bool lat = row0 < TL;
    const float* hin = lat ? a.hin_lat + (size_t)row0 * D : a.hin_ctx + (size_t)(row0 - TL) * D;
    float* hout = lat ? a.hout_lat + (size_t)row0 * D : a.hout_ctx + (size_t)(row0 - TL) * D;
    const bf16_t* hinb = a.hin_bf + (size_t)row0 * D; bf16_t* houtb = a.hout_bf + (size_t)row0 * D;
    const bool hasR = a.R != nullptr, hasA = a.A != nullptr;
    const bf16_t* Rp = a.R + (size_t)row0 * D;
    f32x4 gg[4], gs[4], sh[4];
#pragma unroll
    for (int q = 0; q < 4; ++q) { const int col = 4 * lane + 256 * q;
        if (hasR) gg[q] = *(const f32x4*)(a.modA + (size_t)bi * 6144 + a.gate_off + col) * *(const f32x4*)(a.gainA + col);
        if (hasA) { gs[q] = *(const f32x4*)(a.gainB + col) * (*(const f32x4*)(a.modB + (size_t)bi * 6144 + a.scale_off + col) + 1.f); sh[q] = *(const f32x4*)(a.modB + (size_t)bi * 6144 + a.shift_off + col); } }
    f32x4 nh[RP][4]; u32x2 nhb[RP][4]; u32x2 nr[RP][4];
#define ROW_LOAD(i0) do { _Pragma("unroll") for (int r = 0; r < RP; ++r) _Pragma("unroll") for (int q = 0; q < 4; ++q) { \
        if (HINBF) nhb[r][q] = __builtin_nontemporal_load((const u32x2*)(hinb + (size_t)((i0) + r) * D + 4 * lane + 256 * q)); else nh[r][q] = __builtin_nontemporal_load((const f32x4*)(hin + (size_t)((i0) + r) * D + 4 * lane + 256 * q)); \
        if (hasR && lat) nr[r][q] = __builtin_nontemporal_load((const u32x2*)(Rp + (size_t)((i0) + r) * D + 4 * lane + 256 * q)); } } while (0)
    ROW_LOAD(0);
    for (int i = 0; i < n; i += RP) {
        f32x4 hv[RP][4]; u32x2 rw[RP][4];
#pragma unroll
        for (int r = 0; r < RP; ++r)
#pragma unroll
            for (int q = 0; q < 4; ++q) { if (HINBF) { hv[r][q][0] = bflo(nhb[r][q][0]); hv[r][q][1] = bfhi(nhb[r][q][0]); hv[r][q][2] = bflo(nhb[r][q][1]); hv[r][q][3] = bfhi(nhb[r][q][1]); } else hv[r][q] = nh[r][q]; rw[r][q] = nr[r][q]; }
        if (i + RP < n) ROW_LOAD(i + RP);
#pragma unroll
        for (int r = 0; r < RP; ++r) {
            if (hasR) {
                f32x4 rv[4]; float ss = 0.f;
#pragma unroll
                for (int q = 0; q < 4; ++q) {
                    if (lat) { rv[q][0] = bflo(rw[r][q][0]); rv[q][1] = bfhi(rw[r][q][0]); rv[q][2] = bflo(rw[r][q][1]); rv[q][3] = bfhi(rw[r][q][1]); }
                    else { const float* pp = a.part + (size_t)(row0 - TL + i + r) * 1024 + 4 * lane + 256 * q;
                        rv[q] = *(const f32x4*)pp + *(const f32x4*)(pp + (size_t)2048 * 1024) + *(const f32x4*)(pp + (size_t)2 * 2048 * 1024) + *(const f32x4*)(pp + (size_t)3 * 2048 * 1024); }
                    ss += rv[q][0] * rv[q][0] + rv[q][1] * rv[q][1] + rv[q][2] * rv[q][2] + rv[q][3] * rv[q][3]; }
                ss = wave_sum(ss); const float rinv = rsqrtf(ss * (1.f / 1024.f) + 1e-6f);
#pragma unroll
                for (int q = 0; q < 4; ++q) hv[r][q] += gg[q] * (rv[q] * rinv);
            }
            if (HOUTBF) {
#pragma unroll
                for (int q = 0; q < 4; ++q) { u32x2 o; o[0] = cvt_pk_bf16(hv[r][q][0], hv[r][q][1]); o[1] = cvt_pk_bf16(hv[r][q][2], hv[r][q][3]); __builtin_nontemporal_store(o, (u32x2*)(houtb + (size_t)(i + r) * D + 4 * lane + 256 * q)); }
            } else if (hasR) {
#pragma unroll
                for (int q = 0; q < 4; ++q) __builtin_nontemporal_store(hv[r][q], (f32x4*)(hout + (size_t)(i + r) * D + 4 * lane + 256 * q));
            }
            if (hasA) {
                float ss = 0.f;
#pragma unroll
                for (int q = 0; q < 4; ++q) ss += hv[r][q][0] * hv[r][q][0] + hv[r][q][1] * hv[r][q][1] + hv[r][q][2] * hv[r][q][2] + hv[r][q][3] * hv[r][q][3];
                ss = wave_sum(ss); const float rinv = rsqrtf(ss * (1.f / 1024.f) + 1e-6f);
#pragma unroll
                for (int q = 0; q < 4; ++q) { const f32x4 y = (hv[r][q] * rinv) * gs[q] + sh[q];
                    u32x2 o; o[0] = cvt_pk_bf16(y[0], y[1]); o[1] = cvt_pk_bf16(y[2], y[3]);
                    const int rr = row0 + i + r; const size_t arow = (lat && a.perm) ? (size_t)((rr & ~4095) | ((rr & 63) << 6) | ((rr >> 6) & 63)) : (size_t)rr;
                    *(u32x2*)(a.A + arow * D + 4 * lane + 256 * q) = o; }
            }
        }
    }
#undef ROW_LOAD
}
template <int MODE> __device__ __forceinline__ void row_phase(const RowArgs& a, int G, int bid) {
    const int tid = tid_opaque(), lane = tid & 63, wave = tid >> 6; const int gw = bid * 8 + wave, nw = G * 8;
    for (int c = gw; c < TL / 16; c += nw) rows_seq<2, (MODE >= 2), (MODE == 1 || MODE == 2)>(a, c * 16, 16, (c * 16) >> 12, lane);
    if (a.nrows > TL) for (int r = gw; r < TC; r += nw) rows_seq<1, false, false>(a, TL + r, 1, 8, lane);
}

__device__ __forceinline__ void build_s5(const Params& P, int e, int G, int bid) {
    unsigned char* ws = P.ws; const float* KT = (const float*)(ws + WS_KTAB); const float* BB = (const float*)(ws + WS_BBAR);
    bf16_t* MG = (bf16_t*)(ws + WS_BIG + BG_MG); bf16_t* WST = (bf16_t*)(ws + WS_BIG + BG_WST); const float* AP = (const float*)(ws + WS_APOW);
    const size_t gtid = (size_t)bid * NTHR + tid_opaque(), gn = (size_t)G * NTHR;
#pragma unroll 4
    for (size_t it = gtid; it < (size_t)32 * 1024 * 128; it += gn) {
        const int k8 = (int)(it & 127), n = (int)((it >> 7) & 1023), g = (int)(it >> 17);
        const int i = n >> 4, ho = n & 15, j = k8 >> 1, hi0 = (k8 & 1) * 8;
        const int dir = i >= j ? 0 : 1, l = i >= j ? i - j : j - i; const bool dg = i == j;
        const float* src = KT + ((size_t)((e * 2 + dir) * 32 + g) * 64 + l) * 256 + ho * 16 + hi0;
        const float* s1 = KT + ((size_t)((e * 2 + 1) * 32 + g) * 64) * 256 + ho * 16 + hi0;
        const f32x4 x0 = *(const f32x4*)src, x1 = *(const f32x4*)(src + 4);
        f32x4 y0 = {0.f, 0.f, 0.f, 0.f}, y1 = {0.f, 0.f, 0.f, 0.f}; float dv = 0.f;
        if (dg) { y0 = *(const f32x4*)s1; y1 = *(const f32x4*)(s1 + 4); dv = P.s5_d[e * 512 + g * 16 + ho]; }
        f32x4 v0 = x0 + y0, v1 = x1 + y1;
        if (dg) { if (ho < 8) { if (hi0 == 0) v0[ho & 3] += (ho < 4) ? dv : 0.f, v1[ho & 3] += (ho >= 4) ? dv : 0.f; } else { if (hi0 == 8) v0[ho & 3] += (ho < 12) ? dv : 0.f, v1[ho & 3] += (ho >= 12) ? dv : 0.f; } }
        *(u32x4*)(MG + ((size_t)(g * 1024 + n)) * ULD + k8 * 8) = pack8(v0, v1);
    }
#pragma unroll 2
    for (size_t it = gtid; it < (size_t)32 * 1024 * 32; it += gn) {
        const int k8 = 128 + (int)(it & 31), n = (int)((it >> 5) & 1023), g = (int)(it >> 15);
        const int i = n >> 4, ho = n & 15; float v[8];
        { const int kk0 = (k8 - 128) * 8, dir = kk0 >> 7, p0 = (kk0 & 127) >> 1; const int pw = dir == 0 ? (i + 1) : (64 - i);
            const int gi = (e * 2 + dir) * 32 + g;
            const f32x4 a01 = *(const f32x4*)(AP + ((size_t)(gi * 65 + pw) * 64 + p0) * 2), a23 = *(const f32x4*)(AP + ((size_t)(gi * 65 + pw) * 64 + p0) * 2 + 4);
            const f32x4 cr = *(const f32x4*)(P.c_re + (size_t)(gi * 16 + ho) * 64 + p0), ci = *(const f32x4*)(P.c_im + (size_t)(gi * 16 + ho) * 64 + p0);
            v[0] = cr[0] * a01[0] - ci[0] * a01[1]; v[1] = -(cr[0] * a01[1] + ci[0] * a01[0]);
            v[2] = cr[1] * a01[2] - ci[1] * a01[3]; v[3] = -(cr[1] * a01[3] + ci[1] * a01[2]);
            v[4] = cr[2] * a23[0] - ci[2] * a23[1]; v[5] = -(cr[2] * a23[1] + ci[2] * a23[0]);
            v[6] = cr[3] * a23[2] - ci[3] * a23[3]; v[7] = -(cr[3] * a23[3] + ci[3] * a23[2]); }
        u32x4 o; o[0] = cvt_pk_bf16(v[0], v[1]); o[1] = cvt_pk_bf16(v[2], v[3]); o[2] = cvt_pk_bf16(v[4], v[5]); o[3] = cvt_pk_bf16(v[6], v[7]);
        *(u32x4*)(MG + ((size_t)(g * 1024 + n)) * ULD + k8 * 8) = o;
    }
#pragma unroll 4
    for (size_t it = gtid; it < (size_t)32 * 256 * 128; it += gn) {
        const int k8 = (int)(it & 127), n = (int)((it >> 7) & 255), g = (int)(it >> 15);
        const int dir = n >> 7, p = (n & 127) >> 1, c = n & 1, j = k8 >> 1, hi0 = (k8 & 1) * 8; const int gi = (e * 2 + dir) * 32 + g;
        const f32x2 aa = *(const f32x2*)(AP + ((size_t)(gi * 65 + (dir == 0 ? 63 - j : j)) * 64 + p) * 2); const float ar = aa[0], ai = aa[1];
        const float* bb = BB + ((size_t)gi * 1024 + p * 16 + hi0) * 2; float v[8];
#pragma unroll
        for (int q = 0; q < 8; ++q) { const float br = bb[2 * q], bi = bb[2 * q + 1]; v[q] = c == 0 ? (ar * br - ai * bi) : (ar * bi + ai * br); }
        u32x4 o; o[0] = cvt_pk_bf16(v[0], v[1]); o[1] = cvt_pk_bf16(v[2], v[3]); o[2] = cvt_pk_bf16(v[4], v[5]); o[3] = cvt_pk_bf16(v[6], v[7]);
        *(u32x4*)(WST + ((size_t)(g * 256 + n)) * 1024 + k8 * 8) = o;
    }
}

__device__ __forceinline__ void carry_phase(const Params& P, int e, int G, int bid) {
    unsigned char* ws = P.ws; bf16_t* U = (bf16_t*)(ws + WS_BIG + BG_U); const float* SL = (const float*)(ws + WS_BIG + BG_SLOC); const float* AP = (const float*)(ws + WS_APOW);
    const int tid = tid_opaque(), lane = tid & 63, wave = tid >> 6;
    for (int wt = wave * G + bid; wt < 512; wt += 8 * G) {
        const int dir = wt & 1, g = (wt >> 1) & 31, b = wt >> 6, p = lane; const int gi = (e * 2 + dir) * 32 + g;
        const f32x2 aa = *(const f32x2*)(AP + ((size_t)(gi * 65 + 64) * 64 + p) * 2); const float ar = aa[0], ai = aa[1];
        float sr = 0.f, si = 0.f;
        for (int s17 = 0; s17 < 4; ++s17) {
            f32x2 sl[17];
#pragma unroll
            for (int q = 0; q < 17; ++q) { const int step = s17 * 17 + q; const int row = step < 4 ? 512 + 4 * b + (dir ? 3 - step : step) : 64 * b + (dir ? 63 - (step - 4) : step - 4);
                sl[q] = *(const f32x2*)(SL + ((size_t)(g * UROWS + row) * 256 + dir * 128 + 2 * p)); }
#pragma unroll
            for (int q = 0; q < 17; ++q) { const int step = s17 * 17 + q; const int row = step < 4 ? 512 + 4 * b + (dir ? 3 - step : step) : 64 * b + (dir ? 63 - (step - 4) : step - 4);
                *(unsigned*)(U + ((size_t)(g * UROWS + row) * ULD + 1024 + dir * 128 + 2 * p)) = cvt_pk_bf16(sr, si);
                const float nr = ar * sr - ai * si + sl[q][0], ni = ar * si + ai * sr + sl[q][1]; sr = nr; si = ni; }
        }
    }
}

template <int NB> struct NaS { f32x4 v[2][NB]; };
__device__ __forceinline__ void na_unit_dummy() {}
__device__ __forceinline__ void na_phase(const Params& P, LAS unsigned char* lds, int e, bool ctx_out, int G, int bid) {
    unsigned char* ws = P.ws; const bf16_t* QK = (const bf16_t*)(ws + WS_BIG + BG_QKV); const bf16_t* VT = QK + (size_t)TT * 1024; bf16_t* MO = (bf16_t*)(ws + WS_ABUF);
    const float* rpb = P.rpb + (size_t)e * 8 * 15 * 31;
    const int tid = tid_opaque(), lane = tid & 63, wave = tid >> 6, hs = wave >> 2, w4 = wave & 3, lq = lane & 15, lg = lane >> 4;
    constexpr int KBUF = 2 * 64 * 72 * 2;
    constexpr int TILE_B = 2 * KBUF;
    constexpr int RPB_OFF = 2 * TILE_B;
    LAS float* rpbs = (LAS float*)(lds + RPB_OFF);
    for (int i = tid; i < 8 * 15 * 31; i += NTHR) rpbs[i] = rpb[i] * 1.4426950408889634f;
#define KKEY(i) ((tid >> 4) + 32 * (i))
#define KHSL(i) ((tid >> 3) & 1)
#define KD0(i)  ((tid & 7) * 8)
#define VHSL(i) (i)
#define VDV(i)  ((tid >> 3) & 63)
#define VK8(i)  (tid & 7)
    const int koff = min(max(16 * w4 - 8, 0), 32);
    const int qc = 16 * w4 + lq, c0 = min(max(qc - 8, 0), 48);
    const int nlu = (1024 - bid + G - 1) / G, vb = (bid + G - 32) % G, ncu = (ctx_out && vb < 64) ? (64 - vb + G - 1) / G : 0;
    for (int it = 0; it < nlu + ncu; ++it) {
        const int u = it < nlu ? bid + it * G : 1024 + vb + (it - nlu) * G;
        int b, hp, qtokA, qtokB, r = 0, ra0 = 0, dlt = 0, npair; const bool islat = u < 1024;
        if (islat) { b = u >> 7; r = ((u >> 2) & 31) * 2; hp = u & 3; qtokA = b * 4096 + r * 64; qtokB = qtokA + 64; ra0 = min(max(r - 4, 0), 56); dlt = min(max(r - 3, 0), 56) - ra0; npair = 7; }
        else { const int v = u - 1024; b = v >> 3; const int qb2 = (v >> 2) & 1; hp = v & 3; qtokA = TL + b * 256 + qb2 * 128; qtokB = qtokA + 64; npair = 2; }
        const int head = 2 * hp + hs;
        bf16x8 qf[2][2];
        { const bf16_t* qpA = QK + (size_t)(qtokA + 16 * w4 + lq) * 1024 + head * 64 + 8 * lg; const bf16_t* qpB = QK + (size_t)(qtokB + 16 * w4 + lq) * 1024 + head * 64 + 8 * lg;
          qf[0][0] = *(const bf16x8*)qpA; qf[0][1] = *(const bf16x8*)(qpA + 32); qf[1][0] = *(const bf16x8*)qpB; qf[1][1] = *(const bf16x8*)(qpB + 32); }
        f32x4 O[2][4];
#pragma unroll
        for (int g2 = 0; g2 < 2; ++g2)
#pragma unroll
            for (int i = 0; i < 4; ++i) O[g2][i] = (f32x4){0.f, 0.f, 0.f, 0.f};
        float mrun[2] = {-1e30f, -1e30f}, lrun[2] = {0.f, 0.f};
        u32x4 kreg[2][2], vreg[2][2];
#define NA_KTOK(t) (islat ? ((t) < 10 ? b * 4096 + min(ra0 + (t), 63) * 64 : TL + b * 256 + ((t) - 10) * 64) : TL + b * 256 + (t) * 64)
#define NA_LOAD(pr) do { _Pragma("unroll") for (int s_ = 0; s_ < 2; ++s_) { const int _kt = NA_KTOK(2 * (pr) + s_); _Pragma("unroll") for (int i = 0; i < 2; ++i) { \
            kreg[s_][i] = *(const u32x4*)(QK + (size_t)(_kt + KKEY(i)) * 1024 + 512 + (2 * hp + KHSL(i)) * 64 + KD0(i)); \
            vreg[s_][i] = *(const u32x4*)(VT + (size_t)((2 * hp + VHSL(i)) * 64 + VDV(i)) * TT + _kt + VK8(i) * 8); } } } while (0)
#define NA_WRITE() do { _Pragma("unroll") for (int s_ = 0; s_ < 2; ++s_) _Pragma("unroll") for (int i = 0; i < 2; ++i) { \
            *(LAS u32x4*)(lds + s_ * TILE_B + ((KHSL(i) * 64 + KKEY(i)) * 72 + KD0(i)) * 2) = kreg[s_][i]; \
            *(LAS u32x4*)(lds + s_ * TILE_B + KBUF + ((VHSL(i) * 64 + VDV(i)) * 72 + VK8(i) * 8) * 2) = vreg[s_][i]; } } while (0)
        NA_LOAD(0);
        for (int pr = 0; pr < npair; ++pr) {
            __syncthreads();
            NA_WRITE();
            __syncthreads();
            if (pr + 1 < npair) NA_LOAD(pr + 1);
            if (islat && pr < 5) {
#pragma unroll
                for (int g2 = 0; g2 < 2; ++g2) {
                    const int t0 = 2 * pr, lo = g2 ? dlt : 0, hi = lo + 7;
                    const bool act0 = (t0 >= lo) && (t0 <= hi), act1 = (t0 + 1 >= lo) && (t0 + 1 <= hi);
                    if (act0 || act1) {
                        f32x4 S[2][2];
#pragma unroll
                        for (int s_ = 0; s_ < 2; ++s_) { const bool act = s_ ? act1 : act0; const int dr = (ra0 + t0 + s_) - (r + g2) + 7; const LAS float* bp = rpbs + (head * 15 + min(max(dr, 0), 14)) * 31;
#pragma unroll
                            for (int kb = 0; kb < 2; ++kb) { S[s_][kb] = (f32x4){0.f, 0.f, 0.f, 0.f};
                                const LAS unsigned char* ka = lds + s_ * TILE_B + ((hs * 64 + koff + 16 * kb + lq) * 72 + 8 * lg) * 2;
                                const bf16x8 a0 = *(const LAS bf16x8*)ka, a1 = *(const LAS bf16x8*)(ka + 64);
                                __builtin_amdgcn_s_setprio(1);
                                S[s_][kb] = __builtin_amdgcn_mfma_f32_16x16x32_bf16(a0, qf[g2][0], S[s_][kb], 0, 0, 0);
                                S[s_][kb] = __builtin_amdgcn_mfma_f32_16x16x32_bf16(a1, qf[g2][1], S[s_][kb], 0, 0, 0);
                                __builtin_amdgcn_s_setprio(0);
#pragma unroll
                                for (int v = 0; v < 4; ++v) { const int kc = koff + 16 * kb + 4 * lg + v; const bool ok = act && ((unsigned)(kc - c0) < 16u);
                                    S[s_][kb][v] = ok ? S[s_][kb][v] + bp[kc - qc + 15] : -1e30f; } } }
                        float tmax = -1e30f;
#pragma unroll
                        for (int s_ = 0; s_ < 2; ++s_)
#pragma unroll
                            for (int kb = 0; kb < 2; ++kb)
#pragma unroll
                                for (int v = 0; v < 4; ++v) tmax = fmaxf(tmax, S[s_][kb][v]);
                        tmax = fmaxf(tmax, __shfl_xor(tmax, 16)); tmax = fmaxf(tmax, __shfl_xor(tmax, 32));
                        const float mnew = fmaxf(mrun[g2], tmax), alpha = __builtin_amdgcn_exp2f(mrun[g2] - mnew); mrun[g2] = mnew;
                        float lsum = 0.f;
#pragma unroll
                        for (int s_ = 0; s_ < 2; ++s_)
#pragma unroll
                            for (int kb = 0; kb < 2; ++kb)
#pragma unroll
                                for (int v = 0; v < 4; ++v) { const float pv = __builtin_amdgcn_exp2f(S[s_][kb][v] - mnew); S[s_][kb][v] = pv; lsum += pv; }
                        lrun[g2] = lrun[g2] * alpha + lsum;
#pragma unroll
                        for (int i = 0; i < 4; ++i) O[g2][i] *= alpha;
#pragma unroll
                        for (int s_ = 0; s_ < 2; ++s_) { const u32x4 pk = pack8(S[s_][0], S[s_][1]); const bf16x8 pbv = __builtin_bit_cast(bf16x8, pk);
#pragma unroll
                            for (int dvb = 0; dvb < 4; ++dvb) { const LAS unsigned char* va = lds + s_ * TILE_B + KBUF + ((hs * 64 + 16 * dvb + lq) * 72 + koff + 4 * lg) * 2;
                                const u32x2 x0 = *(const LAS u32x2*)va, x1 = *(const LAS u32x2*)(va + 32); u32x4 av; av[0] = x0[0]; av[1] = x0[1]; av[2] = x1[0]; av[3] = x1[1];
                                __builtin_amdgcn_s_setprio(1); O[g2][dvb] = __builtin_amdgcn_mfma_f32_16x16x32_bf16(__builtin_bit_cast(bf16x8, av), pbv, O[g2][dvb], 0, 0, 0); __builtin_amdgcn_s_setprio(0); } }
                    }
                }
            } else {
#pragma unroll
                for (int s_ = 0; s_ < 2; ++s_)
#pragma unroll
                    for (int g2 = 0; g2 < 2; ++g2) {
                        f32x4 S[4];
#pragma unroll
                        for (int kb = 0; kb < 4; ++kb) { S[kb] = (f32x4){0.f, 0.f, 0.f, 0.f};
                            const LAS unsigned char* ka = lds + s_ * TILE_B + ((hs * 64 + 16 * kb + lq) * 72 + 8 * lg) * 2;
                            const bf16x8 a0 = *(const LAS bf16x8*)ka, a1 = *(const LAS bf16x8*)(ka + 64);
                            __builtin_amdgcn_s_setprio(1);
                            S[kb] = __builtin_amdgcn_mfma_f32_16x16x32_bf16(a0, qf[g2][0], S[kb], 0, 0, 0);
                            S[kb] = __builtin_amdgcn_mfma_f32_16x16x32_bf16(a1, qf[g2][1], S[kb], 0, 0, 0);
                            __builtin_amdgcn_s_setprio(0); }
                        float tmax = -1e30f;
#pragma unroll
                        for (int kb = 0; kb < 4; ++kb)
#pragma unroll
                            for (int v = 0; v < 4; ++v) tmax = fmaxf(tmax, S[kb][v]);
                        tmax = fmaxf(tmax, __shfl_xor(tmax, 16)); tmax = fmaxf(tmax, __shfl_xor(tmax, 32));
                        const float mnew = fmaxf(mrun[g2], tmax), alpha = __builtin_amdgcn_exp2f(mrun[g2] - mnew); mrun[g2] = mnew;
                        float lsum = 0.f;
#pragma unroll
                        for (int kb = 0; kb < 4; ++kb)
#pragma unroll
                            for (int v = 0; v < 4; ++v) { const float pv = __builtin_amdgcn_exp2f(S[kb][v] - mnew); S[kb][v] = pv; lsum += pv; }
                        lrun[g2] = lrun[g2] * alpha + lsum;
#pragma unroll
                        for (int i = 0; i < 4; ++i) O[g2][i] *= alpha;
#pragma unroll
                        for (int kk = 0; kk < 2; ++kk) { const u32x4 pk = pack8(S[2 * kk], S[2 * kk + 1]); const bf16x8 pbv = __builtin_bit_cast(bf16x8, pk);
#pragma unroll
                            for (int dvb = 0; dvb < 4; ++dvb) { const LAS unsigned char* va = lds + s_ * TILE_B + KBUF + ((hs * 64 + 16 * dvb + lq) * 72 + 32 * kk + 4 * lg) * 2;
                                const u32x2 x0 = *(const LAS u32x2*)va, x1 = *(const LAS u32x2*)(va + 32); u32x4 av; av[0] = x0[0]; av[1] = x0[1]; av[2] = x1[0]; av[3] = x1[1];
                                __builtin_amdgcn_s_setprio(1); O[g2][dvb] = __builtin_amdgcn_mfma_f32_16x16x32_bf16(__builtin_bit_cast(bf16x8, av), pbv, O[g2][dvb], 0, 0, 0); __builtin_amdgcn_s_setprio(0); } }
                    }
            }
        }
#undef NA_KTOK
#undef NA_LOAD
#undef NA_WRITE
#pragma unroll
        for (int g2 = 0; g2 < 2; ++g2) {
            float lr = lrun[g2]; lr += __shfl_xor(lr, 16); lr += __shfl_xor(lr, 32);
            const float inv = 1.f / lr;
            bf16_t* op = MO + (size_t)((g2 ? qtokB : qtokA) + 16 * w4 + lq) * 1024 + 512 + head * 64 + 4 * lg;
#pragma unroll
            for (int dvb = 0; dvb < 4; ++dvb) { u32x2 o; o[0] = cvt_pk_bf16(O[g2][dvb][0] * inv, O[g2][dvb][1] * inv); o[1] = cvt_pk_bf16(O[g2][dvb][2] * inv, O[g2][dvb][3] * inv); *(u32x2*)(op + 16 * dvb) = o; }
        }
    }
    __syncthreads();
}

#define XB_TMO      128
#define XB_XCNT(j)  (256  + 64 * (j))
#define XB_XSUB(j)  (1280 + 64 * (j))
#define XB_XGEN(j)  (2304 + 64 * (j))
#define XB_TOP      3328
#define XB_TOPGEN   3392
#define XCD_BAR_WORDS 3456
#define XB_SPIN_CAP (1u << 18)
__device__ __forceinline__ unsigned xb_ld(unsigned* p)              { return __hip_atomic_load(p, __ATOMIC_RELAXED, __HIP_MEMORY_SCOPE_AGENT); }
__device__ __forceinline__ unsigned xb_add(unsigned* p, unsigned v) { return __hip_atomic_fetch_add(p, v, __ATOMIC_RELAXED, __HIP_MEMORY_SCOPE_AGENT); }
__device__ __forceinline__ unsigned xb_xcc_id() { return (unsigned)__builtin_amdgcn_s_getreg((3 << 11) | 20) & 0xFu; }
#define XB_SPIN(cond, bar) do { unsigned _sp = 0; while (cond) { __builtin_amdgcn_s_sleep(1); \
    if ((++_sp & 255u) == 0u) { if (xb_ld(&(bar)[XB_TMO])) break; if (_sp > XB_SPIN_CAP) { atomicAdd(&(bar)[XB_TMO], 1u); break; } } } } while (0)
struct XcdBarrier { unsigned* bar; unsigned x; volatile LAS unsigned* st; };
__device__ __forceinline__ XcdBarrier xcd_barrier_post(unsigned* bar, volatile LAS unsigned* st) {
    XcdBarrier b; b.bar = bar; b.x = xb_xcc_id(); b.st = st;
    if (threadIdx.x == 0) (void)xb_add(&bar[XB_XCNT(b.x)], 1u);
    return b;
}
__device__ __forceinline__ void xcd_barrier_complete(unsigned* bar, unsigned x, unsigned& nloc, unsigned& nx) {
    const unsigned G = gridDim.x * gridDim.y * gridDim.z;
    unsigned sum, cnt, mine, sp = 0u;
    for (;;) {
        sum = 0u; cnt = 0u; mine = 0u;
#pragma unroll
        for (unsigned j = 0; j < 16; ++j) { const unsigned c = xb_ld(&bar[XB_XCNT(j)]); sum += c; cnt += (c > 0u) ? 1u : 0u; mine = (j == x) ? c : mine; }
        if (sum == G) break;
        __builtin_amdgcn_s_sleep(1);
        if ((++sp & 255u) == 0u) { if (xb_ld(&bar[XB_TMO])) break; if (sp > XB_SPIN_CAP) { atomicAdd(&bar[XB_TMO], 1u); break; } }
    }
    nloc = mine > 0u ? mine : 1u; nx = cnt > 0u ? cnt : 1u;
}
__device__ __attribute__((noinline)) void xcd_barrier_fn(unsigned* bar_, unsigned x_, unsigned stoff) {
    XcdBarrier b; b.bar = bar_; b.x = x_; b.st = (volatile LAS unsigned*)(unsigned long)stoff;
    asm volatile("s_waitcnt vmcnt(0)" ::: "memory");
    __syncthreads();
    if (threadIdx.x == 0) {
        unsigned* bar = b.bar;
        __builtin_amdgcn_s_waitcnt(0);
        unsigned nloc = b.st[0], nx = b.st[1];
        if (nloc == 0u) { xcd_barrier_complete(bar, b.x, nloc, nx); b.st[0] = nloc; b.st[1] = nx; }
        const unsigned old = xb_add(&bar[XB_XSUB(b.x)], 1u);
        const unsigned gen = old / nloc;
        if (old + 1u == (gen + 1u) * nloc) {
            __builtin_amdgcn_fence(__ATOMIC_RELEASE, "agent");
            asm volatile("s_waitcnt vmcnt(0)" ::: "memory");
            const unsigned og = xb_add(&bar[XB_TOP], 1u);
            const unsigned tg = og / nx;
            if (og + 1u == (tg + 1u) * nx) xb_add(&bar[XB_TOPGEN], 1u);
            else XB_SPIN(xb_ld(&bar[XB_TOPGEN]) == tg, bar);
            __builtin_amdgcn_fence(__ATOMIC_ACQUIRE, "agent");
            xb_add(&bar[XB_XGEN(b.x)], 1u);
            asm volatile("s_waitcnt vmcnt(0)" ::: "memory");
        } else {
            XB_SPIN(xb_ld(&bar[XB_XGEN(b.x)]) == gen, bar);
            __builtin_amdgcn_fence(__ATOMIC_ACQUIRE, "agent");
            asm volatile("s_waitcnt vmcnt(0)" ::: "memory");
        }
    }
    __syncthreads();
}


__device__ __forceinline__ const float* ldp(volatile LAS unsigned* q, int i) {
    const unsigned lo = __builtin_amdgcn_readfirstlane(q[2 * i]), hi = __builtin_amdgcn_readfirstlane(q[2 * i + 1]);
    return (const float*)(((unsigned long)hi << 32) | lo);
}
__device__ __forceinline__ Params load_params(LAS unsigned char* lds) {
    volatile LAS unsigned* q = (volatile LAS unsigned*)(lds + LDS_PARAM);
    Params P;
    P.x = ldp(q, 0); P.c = ldp(q, 1); P.ctx = ldp(q, 2); P.c_ctx = ldp(q, 3); P.w_mod = ldp(q, 4); P.b_mod = ldp(q, 5); P.norm_g = ldp(q, 6);
    P.w_in = ldp(q, 7); P.w_out = ldp(q, 8); P.lam_re = ldp(q, 9); P.lam_im = ldp(q, 10); P.log_dt = ldp(q, 11); P.b_re = ldp(q, 12); P.b_im = ldp(q, 13);
    P.c_re = ldp(q, 14); P.c_im = ldp(q, 15); P.s5_d = ldp(q, 16); P.w_glu = ldp(q, 17); P.rpb = ldp(q, 18); P.w_f = ldp(q, 19); P.w_ff1 = ldp(q, 20); P.w_ff2 = ldp(q, 21);
    P.out = (float*)ldp(q, 22); P.ws = (unsigned char*)ldp(q, 23);
    return P;
}
__global__ void __launch_bounds__(NTHR, 2) mega(Params Pk) {
    extern __shared__ __attribute__((aligned(16))) unsigned char shm[];
    LAS unsigned char* lds = (LAS unsigned char*)shm;
    cg::grid_group grid = cg::this_grid();
    if (threadIdx.x == 0) { volatile LAS unsigned long* q = (volatile LAS unsigned long*)(lds + LDS_PARAM);
        q[0] = (unsigned long)Pk.x; q[1] = (unsigned long)Pk.c; q[2] = (unsigned long)Pk.ctx; q[3] = (unsigned long)Pk.c_ctx; q[4] = (unsigned long)Pk.w_mod; q[5] = (unsigned long)Pk.b_mod;
        q[6] = (unsigned long)Pk.norm_g; q[7] = (unsigned long)Pk.w_in; q[8] = (unsigned long)Pk.w_out; q[9] = (unsigned long)Pk.lam_re; q[10] = (unsigned long)Pk.lam_im; q[11] = (unsigned long)Pk.log_dt;
        q[12] = (unsigned long)Pk.b_re; q[13] = (unsigned long)Pk.b_im; q[14] = (unsigned long)Pk.c_re; q[15] = (unsigned long)Pk.c_im; q[16] = (unsigned long)Pk.s5_d; q[17] = (unsigned long)Pk.w_glu;
        q[18] = (unsigned long)Pk.rpb; q[19] = (unsigned long)Pk.w_f; q[20] = (unsigned long)Pk.w_ff1; q[21] = (unsigned long)Pk.w_ff2; q[22] = (unsigned long)Pk.out; q[23] = (unsigned long)Pk.ws; }
    { volatile LAS unsigned* st0 = (volatile LAS unsigned*)(lds + LDS_STAGE); if (threadIdx.x < 16) st0[threadIdx.x] = 0u; }
    __syncthreads();
    if (blockIdx.x == 0) { unsigned* bw = (unsigned*)(Pk.ws + WS_BAR); for (int i = threadIdx.x; i < XCD_BAR_WORDS; i += NTHR) bw[i] = 0u; }
#define PHASE_BEGIN { const Params P = load_params(lds); int G = gridDim.x, bid = blockIdx.x; asm volatile("" : "+s"(G), "+s"(bid)); unsigned char* ws = P.ws; \
        bf16_t* ABUF = (bf16_t*)(ws + WS_ABUF); float* SCTX = (float*)(ws + WS_SCTX); const float* MOD = (const float*)(ws + WS_MOD); (void)ABUF; (void)SCTX; (void)MOD; (void)G; (void)bid;
#define PHASE_END   xcd_barrier_fn((unsigned*)(ws + WS_BAR), xb_xcc_id(), (unsigned)LDS_STAGE); }
#define PHASE_END_CG grid.sync(); }
#define PHASE_END_LAST }

    PHASE_BEGIN DUP(8, phase0(P, lds, G, bid)); PHASE_END_CG
    { const Params P = load_params(lds); (void)xcd_barrier_post((unsigned*)(P.ws + WS_BAR), (volatile LAS unsigned*)(lds + LDS_STAGE)); }
    PHASE_BEGIN
        RowArgs a{}; a.hin_lat = P.x; a.hin_ctx = P.ctx; a.hout_lat = (float*)P.x; a.hout_ctx = (float*)P.ctx; a.R = nullptr; a.A = ABUF; a.modB = MOD; a.shift_off = 0; a.scale_off = 1024; a.gainB = P.norm_g; a.nrows = TT;
        row_phase<0>(a, G, bid);
    PHASE_END

    for (int L = 0; L < 4; ++L) {
        const bool upd_ctx = L < 2;
        const int MT = upd_ctx ? TT / 256 : TL / 256;
#define HB_  ((bf16_t*)(ws + WS_W1))
#define W1T_ ((const bf16_t*)P.out)
#define W2T_ ((const bf16_t*)P.out + (size_t)4 * 4096 * 1024)
#define MODL (MOD + (size_t)L * 9 * 6144)
#define NGL  (P.norm_g + (size_t)L * 4 * 1024)
#define BIGP (ws + WS_BIG)
#define U_   ((bf16_t*)(BIGP + BG_U))
#define QKV_ ((bf16_t*)(BIGP + BG_QKV))
#define GB_  ((bf16_t*)(BIGP + BG_G))
#define RBE_ ((bf16_t*)(BIGP + BG_R))
#define ZA_  ((bf16_t*)(BIGP + BO_ZA))
#define YC_  ((bf16_t*)(BIGP + BO_YC))
#define PQC_ ((bf16_t*)(BIGP + BO_PQC))
#define AODD_ ((bf16_t*)(BIGP + BO_YC))
#define RBO_ ((bf16_t*)(BIGP + BO_R))
        if ((L & 1) == 0) {
            const int e = L >> 1;
            PHASE_BEGIN
                { const int skip = (1088 % G) < G / 2 ? (1088 % G) : 0;
                  if (bid >= skip) DUP(16, build_s5(P, e, G - skip, bid - skip)); }
                Gemm g{ABUF, (const bf16_t*)(ws + WS_WIN) + (size_t)e * 2048 * 1024, 0, 0, 1024, 1024, TT / 256, 8, 1, 1024};
                Epi<M_WIN> E{0, U_, QKV_, nullptr, 0.f}; DUP(1, gemm_phase(lds, g, E, G, bid));
            PHASE_END
            PHASE_BEGIN
                Gemm g{U_, (const bf16_t*)(BIGP + BG_WST), (long)UROWS * ULD, 256L * 1024, ULD, 1024, 3, 1, 32, 1024};
                Epi<M_SLOC> E{0, BIGP + BG_SLOC, nullptr, nullptr, 0.f}; DUP(1, gemm_phase(lds, g, E, G, (bid + 96) % G));
                DUP(4, na_phase(P, lds, e, upd_ctx, G, bid));
            PHASE_END
            PHASE_BEGIN DUP(16, carry_phase(P, e, G, bid)); PHASE_END
            PHASE_BEGIN
                Gemm g{U_, (const bf16_t*)(BIGP + BG_MG), (long)UROWS * ULD, 1024L * ULD, ULD, ULD, upd_ctx ? 3 : 2, 4, 32, ULD};
                Epi<M_YG> E{upd_ctx ? UROWS : 512, GB_, nullptr, nullptr, 0.f}; DUP(1, gemm_phase(lds, g, E, G, bid));
            PHASE_END
            PHASE_BEGIN
                Gemm g{GB_, (const bf16_t*)(ws + WS_WGLU) + (size_t)e * 512 * 512, 0, 0, 512, 512, MT, 2, 1, 512};
                Epi<M_GLU> E{0, ABUF, nullptr, GB_, 0.f}; DUP(1, gemm_phase(lds, g, E, G, bid));
            PHASE_END
            PHASE_BEGIN
                Gemm g{ABUF, (const bf16_t*)(ws + WS_WOUT) + (size_t)e * 1024 * 1024, 0, 0, 1024, 1024, TL / 256, 4, 1, 1024};
                Epi<M_PLAIN> E{1024, RBE_, nullptr, nullptr, 0.f}; DUP(1, gemm_phase(lds, g, E, G, bid));
                if (upd_ctx) { Gemm g2{ABUF + (size_t)TL * 1024, (const bf16_t*)(ws + WS_WOUT) + (size_t)e * 1024 * 1024, 256, 256, 1024, 1024, 8, 4, 4, 256};
                    Epi<M_PART> E2{0, ws + WS_PART, nullptr, nullptr, 0.f}; DUP(1, gemm_phase(lds, g2, E2, G, bid)); }
            PHASE_END
        } else {
            const int o = L >> 1;
            PHASE_BEGIN
                Gemm g{(const bf16_t*)(ws + WS_CDSD), AODD_, 0, 0, 1024, 1024, 4, MT, 1, 1024};
                Epi<M_PQ> E{0, ZA_, PQC_, nullptr, 0.f}; DUP(1, gemm_phase(lds, g, E, G, bid));
            PHASE_END
            PHASE_BEGIN
                Gemm g{(const bf16_t*)(ws + WS_DA), ZA_, 0, 0, 256, 256, 1, 1024, 1, 256};
                Epi<M_FA> E{0, YC_, nullptr, nullptr, 0.f}; DUP(2, gemm_phase(lds, g, E, G, bid));
                if (upd_ctx) { Gemm g2{(const bf16_t*)(ws + WS_AL256), PQC_, 0, 512, 512, 4096, 1, 4, 8, 512};
                    Epi<M_POSC> E2{0, ABUF, nullptr, nullptr, 1.f / 512.f}; DUP(2, gemm_phase(lds, g2, E2, G, bid)); }
            PHASE_END
            PHASE_BEGIN
                Gemm g{(const bf16_t*)(ws + WS_DC), YC_, 0, 0, 512, 512, 1, 512, 1, 512};
                Epi<M_FC> E{0, ABUF, nullptr, nullptr, 1.f / 2048.f}; DUP(2, gemm_phase(lds, g, E, G, bid));
            PHASE_END
            PHASE_BEGIN
                Gemm g{ABUF, (const bf16_t*)(ws + WS_WF) + (size_t)o * 1024 * 1024, 0, 0, 1024, 1024, TL / 256, 4, 1, 1024};
                Epi<M_PLAIN> E{1024, RBO_, nullptr, nullptr, 0.f}; DUP(1, gemm_phase(lds, g, E, G, bid));
                if (upd_ctx) { Gemm g2{ABUF + (size_t)TL * 1024, (const bf16_t*)(ws + WS_WF) + (size_t)o * 1024 * 1024, 256, 256, 1024, 1024, 8, 4, 4, 256};
                    Epi<M_PART> E2{0, ws + WS_PART, nullptr, nullptr, 0.f}; DUP(1, gemm_phase(lds, g2, E2, G, bid)); }
            PHASE_END
        }
        PHASE_BEGIN
            RowArgs a{}; a.hin_lat = P.x; a.hin_ctx = L == 0 ? P.ctx : SCTX; a.hout_lat = nullptr; a.hout_ctx = SCTX; a.hin_bf = HB_; a.hout_bf = HB_; a.R = (L & 1) ? RBO_ : RBE_; a.modA = MODL; a.gate_off = 2048; a.gainA = NGL + 1024;
            a.A = ABUF; a.modB = MODL; a.shift_off = 3072; a.scale_off = 4096; a.gainB = NGL + 2048; a.nrows = MT * 256; a.part = (const float*)(ws + WS_PART);
            if (L == 0) row_phase<1>(a, G, bid); else row_phase<2>(a, G, bid);
        PHASE_END
        PHASE_BEGIN
            Gemm g{ABUF, W1T_ + (size_t)L * 4096 * 1024, 0, 0, 1024, 1024, MT, 16, 1, 1024};
            Epi<M_SQRELU> E{4096, ws + WS_BIG, nullptr, nullptr, 0.f}; DUP(1, gemm_phase(lds, g, E, G, bid));
        PHASE_END
        PHASE_BEGIN
            Gemm g{(const bf16_t*)(ws + WS_BIG), W2T_ + (size_t)L * 1024 * 4096, 0, 0, 4096, 4096, TL / 256, 4, 1, 4096, 1};
            Epi<M_PLAIN> E{1024, ABUF, nullptr, nullptr, 0.f}; DUP(1, gemm_phase(lds, g, E, G, bid));
            if (upd_ctx) { Gemm g2{(const bf16_t*)(ws + WS_BIG) + (size_t)TL * 4096, W2T_ + (size_t)L * 1024 * 4096, 1024, 1024, 4096, 4096, 8, 4, 4, 1024};
                Epi<M_PART> E2{0, ws + WS_PART, nullptr, nullptr, 0.f}; DUP(1, gemm_phase(lds, g2, E2, G, bid)); }
        PHASE_END
        PHASE_BEGIN
            RowArgs a{}; a.hin_lat = nullptr; a.hin_ctx = SCTX; a.hout_lat = P.out; a.hout_ctx = SCTX; a.hin_bf = HB_; a.hout_bf = HB_; a.R = ABUF; a.modA = MODL; a.gate_off = 5120; a.gainA = NGL + 3072; a.nrows = MT * 256; a.part = (const float*)(ws + WS_PART);
            if (L < 3) { a.A = ((L + 1) & 1) ? AODD_ : ABUF; a.modB = MOD + (size_t)(L + 1) * 9 * 6144; a.shift_off = 0; a.scale_off = 1024; a.gainB = P.norm_g + (size_t)(L + 1) * 4 * 1024; a.perm = ((L + 1) & 1); } else a.A = nullptr;
            if (L < 3) row_phase<2>(a, G, bid); else row_phase<3>(a, G, bid);
            if (L < 3) xcd_barrier_fn((unsigned*)(ws + WS_BAR), xb_xcc_id(), (unsigned)LDS_STAGE);
        PHASE_END_LAST
    }
}
constexpr int N_PHASES = 2 + 10 + 8 + 10 + 8;

extern "C" void kernel_launch(void* const* d_in, const int* in_sizes, int n_in, void* d_out, int out_size, void* d_ws, size_t ws_size, hipStream_t stream) {
    static int grid = 0;
    if (grid == 0) {
        if (n_in != 22 || ws_size < WS_END) { fprintf(stderr, "kernel_launch: unexpected n_in %d / ws_size %zu (need %zu)\n", n_in, ws_size, (size_t)WS_END); grid = -1; return; }
        int dev = 0, cus = 0, per_cu = 0;
        hipGetDevice(&dev); hipDeviceGetAttribute(&cus, hipDeviceAttributeMultiprocessorCount, dev);
        if (hipFuncSetAttribute((const void*)mega, hipFuncAttributeMaxDynamicSharedMemorySize, LDS_BYTES) != hipSuccess) { fprintf(stderr, "hipFuncSetAttribute failed\n"); grid = -1; return; }
        if (hipOccupancyMaxActiveBlocksPerMultiprocessor(&per_cu, (const void*)mega, NTHR, LDS_BYTES) != hipSuccess || per_cu < 1) { fprintf(stderr, "occupancy query: %d\n", per_cu); per_cu = 1; }
        (void)hipGetLastError();
        grid = cus * 1;
    }
    if (grid < 0) return;
    Params p{};
    const float** pp = (const float**)&p;
    for (int i = 0; i < 22; ++i) pp[i] = (const float*)d_in[i];
    p.out = (float*)d_out; p.ws = (unsigned char*)d_ws;
#if N_LAUNCH_MODE == 1
    void* args[] = {&p};
    hipError_t e = hipLaunchCooperativeKernel((const void*)mega, dim3(grid), dim3(NTHR), args, LDS_BYTES, stream);
    if (e != hipSuccess) fprintf(stderr, "cooperative launch failed: %s (grid %d)\n", hipGetErrorString(e), grid);
#else
    fprintf(stderr, "per-phase launch mode removed\n");
#endif
}
```

```cpp
#include <hip/hip_runtime.h>
#include <hip/hip_cooperative_groups.h>
#include <cstdio>
namespace cg = cooperative_groups;

#ifndef N_LAUNCH_MODE
#define N_LAUNCH_MODE 1
#endif

#ifndef DUPMASK
#define DUPMASK 0
#endif
#define DUP(bit, stmt) do { _Pragma("nounroll") for (int _rep = 0; _rep < ((DUPMASK & (bit)) ? 2 : 1); ++_rep) { stmt; } } while (0)
#define LAS __attribute__((address_space(3)))
typedef unsigned short bf16_t;
typedef short bf16x8 __attribute__((ext_vector_type(8)));
typedef float f32x4 __attribute__((ext_vector_type(4)));
typedef float f32x2 __attribute__((ext_vector_type(2)));
typedef unsigned u32x4 __attribute__((ext_vector_type(4)));
typedef unsigned u32x2 __attribute__((ext_vector_type(2)));

constexpr int D = 1024, TL = 32768, TC = 2048, TT = 34816, DFF = 4096;
constexpr int NTHR = 512;
constexpr int LDS_STAGE = 131072;
constexpr int LDS_PARAM = LDS_STAGE + 64;
constexpr int LDS_BYTES = LDS_PARAM + 256;
constexpr size_t MiB = 1048576;
constexpr size_t WS_SCTX = 0, WS_MOD = 8 * MiB, WS_WIN = 9 * MiB, WS_WOUT = 17 * MiB, WS_WGLU = 21 * MiB, WS_WF = 22 * MiB,
                 WS_W1 = 26 * MiB, WS_W2 = 58 * MiB, WS_CDSD = 90 * MiB, WS_AL = 94 * MiB, WS_AL256 = 126 * MiB, WS_KTAB = 127 * MiB,
                 WS_BBAR = 135 * MiB, WS_ABUF = 136 * MiB, WS_BIG = 204 * MiB, WS_BAR = 476 * MiB, WS_PART = 477 * MiB, WS_END = 509 * MiB;
constexpr size_t BG_MG = 0, BG_WST = 80 * MiB, BG_U = 96 * MiB, BG_SLOC = 139 * MiB, BG_QKV = 156 * MiB, BG_G = BG_QKV, BG_R = BG_QKV + 34 * MiB;
constexpr size_t BO_ZA = 0, BO_YC = 128 * MiB, BO_PQC = 256 * MiB, BO_R = 0;
constexpr size_t WS_DA = WS_AL, WS_DC = WS_AL + 1 * MiB, WS_APOW = WS_AL + 2 * MiB;
constexpr int PQ_LD = 69632;
constexpr int UROWS = 544, ULD = 1280;

struct Params {
    const float* x; const float* c; const float* ctx; const float* c_ctx; const float* w_mod; const float* b_mod; const float* norm_g;
    const float* w_in; const float* w_out; const float* lam_re; const float* lam_im; const float* log_dt; const float* b_re; const float* b_im;
    const float* c_re; const float* c_im; const float* s5_d; const float* w_glu; const float* rpb; const float* w_f; const float* w_ff1; const float* w_ff2;
    float* out; unsigned char* ws;
};

__device__ __forceinline__ unsigned cvt_pk_bf16(float lo, float hi) { unsigned r; asm volatile("v_cvt_pk_bf16_f32 %0, %1, %2" : "=v"(r) : "v"(lo), "v"(hi)); return r; }
__device__ __forceinline__ bf16_t f2bf(float f) { return (bf16_t)(cvt_pk_bf16(f, 0.f) & 0xffffu); }
__device__ __forceinline__ float bf2f(unsigned short b) { return __uint_as_float(((unsigned)b) << 16); }
__device__ __forceinline__ float bflo(unsigned w) { return __uint_as_float(w << 16); }
__device__ __forceinline__ float bfhi(unsigned w) { return __uint_as_float(w & 0xffff0000u); }
__device__ __forceinline__ u32x4 pack8(f32x4 a, f32x4 b) { u32x4 r; r[0] = cvt_pk_bf16(a[0], a[1]); r[1] = cvt_pk_bf16(a[2], a[3]); r[2] = cvt_pk_bf16(b[0], b[1]); r[3] = cvt_pk_bf16(b[2], b[3]); return r; }
__device__ __forceinline__ int tid_opaque() { int t = threadIdx.x; asm volatile("" : "+v"(t)); return t; }
__device__ __forceinline__ float wave_sum(float v) { for (int o = 32; o > 0; o >>= 1) v += __shfl_xor(v, o); return v; }
__device__ __forceinline__ float gelu_tanh(float y) { const float z = 0.7978845608028654f * (y + 0.044715f * y * y * y); const float t = 1.f - 2.f / (__expf(2.f * z) + 1.f); return 0.5f * y * (1.f + t); }
__device__ __forceinline__ float sigmoidf(float v) { return 1.f / (1.f + __expf(-v)); }

__device__ __forceinline__ void apow(const Params& P, int e, int dir, int g, int p, float pw, float& ar, float& ai) {
    const int gi = (e * 2 + dir) * 32 + g, idx = gi * 64 + p;
    const float lr = fminf(P.lam_re[idx], -1e-4f), li = P.lam_im[idx], dt = expf(P.log_dt[gi]);
    const float mag = expf(lr * dt * pw);
    double rev = (double)li * (double)dt * (double)pw * 0.15915494309189535; rev -= floor(rev);
    const float ang = (float)rev * 6.283185307179586f;
    ar = mag * cosf(ang); ai = mag * sinf(ang);
}

constexpr int BM = 256, BK = 64, HALF = 128, HTB = HALF * BK * 2, NXCD = 8, WGM = 8;
__device__ __forceinline__ int lds_byte(int r, int c) { const int st = (r >> 4) * 2 + (c >> 5), rr = r & 15, cc = c & 31, ob = rr * 64 + cc * 2; return st * 1024 + (ob ^ (((ob >> 9) & 1) << 5)); }
__device__ __forceinline__ void stage_rc(int b, int& R, int& C) { const int st = b / 1024, sb = b % 1024, swz = sb ^ (((sb >> 9) & 1) << 5); R = (st >> 1) * 16 + swz / 64; C = (st & 1) * 32 + (swz % 64) / 2; }
__device__ __forceinline__ int perm32(int rho) { const int n = rho >> 4, i = rho & 15; return 8 * (i >> 2) + 4 * n + (i & 3); }

struct Unit { int pm, pn, pb; };
struct Gemm { const bf16_t* A; const bf16_t* Bt; long sA, sB; int lda, ldb, nM, nN, nB, K; int rev = 0; };
struct Order {
    int nM, nN, nwg, total, G, c, rev;
    __device__ void init(const Gemm& g, int G_, int c_) { nM = g.nM; nN = g.nN; nwg = nM * nN; total = nwg * g.nB; G = G_; c = c_; rev = g.rev; }
    __device__ bool next(int i, Unit& u) const {
        const long L = (long)i * G + c; if (L >= total) return false;
        const int pb = (int)(L / nwg); int wgid = (int)(L - (long)pb * nwg);
        { const int q = nwg / NXCD, r = nwg % NXCD, xcd = wgid % NXCD, off = wgid / NXCD; wgid = (xcd < r ? xcd * (q + 1) : r * (q + 1) + (xcd - r) * q) + off; }
        const int nig = WGM * nN, gid = wgid / nig, fm = gid * WGM, gsz = (nM - fm) < WGM ? (nM - fm) : WGM;
        u.pm = fm + ((wgid % nig) % gsz); u.pn = (wgid % nig) / gsz; u.pb = pb; if (rev) u.pm = nM - 1 - u.pm; return true;
    }
};

enum { M_PLAIN = 0, M_SQRELU, M_WIN, M_SLOC, M_YG, M_GLU, M_PQ, M_POS, M_POSC, M_PART, M_FA, M_FC };
template <int MODE> struct Epi {
    static constexpr int mode = MODE; int p0; void* o0; void* o1; const void* i0; float f0;
    __device__ __forceinline__ void store8(int pb, int row, int col0, f32x4 v0, f32x4 v1) const {
        switch (mode) {
        case M_PLAIN: { *(u32x4*)((bf16_t*)o0 + (size_t)row * p0 + col0) = pack8(v0, v1); } break;
        case M_SQRELU: {
#pragma unroll
            for (int i = 0; i < 4; ++i) { float a, b; asm("v_max_f32 %0, 0, %1" : "=v"(a) : "v"(v0[i])); asm("v_max_f32 %0, 0, %1" : "=v"(b) : "v"(v1[i])); v0[i] = a; v1[i] = b; }
            v0 *= v0; v1 *= v1;
            *(u32x4*)((bf16_t*)o0 + (size_t)row * p0 + col0) = pack8(v0, v1); } break;
        case M_WIN: {
            if (col0 < 512) { const int g = col0 >> 4, h0 = col0 & 15, r = row >> 6, j = row & 63;
                *(u32x4*)((bf16_t*)o0 + ((size_t)(g * UROWS + r) * ULD + j * 16 + h0)) = pack8(v0, v1); }
            else if (col0 < 1536) { if (col0 < 1024) { v0 *= 0.125f * 1.4426950408889634f; v1 *= 0.125f * 1.4426950408889634f; }
                *(u32x4*)((bf16_t*)o1 + (size_t)row * 1024 + (col0 - 512)) = pack8(v0, v1); }
            else { const u32x4 pk = pack8(v0, v1); bf16_t* vt = (bf16_t*)o1 + (size_t)TT * 1024 + (size_t)(col0 - 1536) * TT + row;
#pragma unroll
                for (int e = 0; e < 8; ++e) { const unsigned w = pk[e >> 1]; vt[(size_t)e * TT] = (bf16_t)((e & 1) ? (w >> 16) : (w & 0xffffu)); } } } break;
        case M_SLOC: { if (row < UROWS) { float* dst = (float*)o0 + ((size_t)(pb * UROWS + row) * 256 + col0); *(f32x4*)dst = v0; *(f32x4*)(dst + 4) = v1; } } break;
        case M_YG: { if (row < p0) { const int token = row < 512 ? row * 64 : TL + (row - 512) * 64; const int i = col0 >> 4, ho0 = col0 & 15;
#pragma unroll
                for (int k = 0; k < 4; ++k) { v0[k] = gelu_tanh(v0[k]); v1[k] = gelu_tanh(v1[k]); }
                *(u32x4*)((bf16_t*)o0 + (size_t)(token + i) * 512 + pb * 16 + ho0) = pack8(v0, v1); } } break;
        case M_GLU: { const u32x4 gv = *(const u32x4*)((const bf16_t*)i0 + (size_t)row * 512 + col0);
            v0[0] = bflo(gv[0]) * sigmoidf(v0[0]); v0[1] = bfhi(gv[0]) * sigmoidf(v0[1]); v0[2] = bflo(gv[1]) * sigmoidf(v0[2]); v0[3] = bfhi(gv[1]) * sigmoidf(v0[3]);
            v1[0] = bflo(gv[2]) * sigmoidf(v1[0]); v1[1] = bfhi(gv[2]) * sigmoidf(v1[1]); v1[2] = bflo(gv[3]) * sigmoidf(v1[2]); v1[3] = bfhi(gv[3]) * sigmoidf(v1[3]);
            *(u32x4*)((bf16_t*)o0 + (size_t)row * 1024 + col0) = pack8(v0, v1); } break;
        case M_PQ: {
            const bool isSin = row >= 513; const int m = isSin ? row - 512 : row; const int co = isSin ? 64 : 0;
            const u32x4 pk = pack8(v0, v1); const u32x4 npk = pack8(-v0, -v1); const u32x4 zz = {0u, 0u, 0u, 0u};
            if (col0 < TL) { bf16_t* ZA = (bf16_t*)o0; const int b = col0 >> 12, pi = col0 & 4095, t2 = pi >> 6, t1 = pi & 63, tp = t2 >> 1, j = t2 & 1;
                const size_t inner = (size_t)tp * 256 + j * 128 + co + t1;
                *(u32x4*)(ZA + (size_t)(b * 1024 + m) * 8192 + inner) = pk;
                if (m >= 1 && m <= 511) *(u32x4*)(ZA + (size_t)(b * 1024 + 1024 - m) * 8192 + inner) = isSin ? npk : pk;
                if (!isSin && (m == 0 || m == 512)) *(u32x4*)(ZA + (size_t)(b * 1024 + m) * 8192 + inner + 64) = zz; }
            else { bf16_t* PC = (bf16_t*)o1; const int tt = col0 - TL, b = tt >> 8, t = tt & 255; const size_t inner = (size_t)b * 512 + (isSin ? 256 : 0) + t;
                *(u32x4*)(PC + (size_t)m * 4096 + inner) = pk;
                if (m >= 1 && m <= 511) *(u32x4*)(PC + (size_t)(1024 - m) * 4096 + inner) = isSin ? npk : pk;
                if (!isSin && (m == 0 || m == 512)) *(u32x4*)(PC + (size_t)m * 4096 + inner + 256) = zz; } } break;
        case M_FC: { v0 *= f0; v1 *= f0; const int jj = row >> 6, k2 = row & 63, m0 = col0 & 1023, kq = (col0 >> 10) & 15, b = col0 >> 14; const int k = 4 * kq + jj + 64 * k2;
            *(u32x4*)((bf16_t*)o0 + ((size_t)(b * 4096 + k)) * 1024 + m0) = pack8(v0, v1); } break;
        case M_POSC: { v0 *= f0; v1 *= f0; *(u32x4*)((bf16_t*)o0 + ((size_t)(TL + pb * 256 + row)) * 1024 + col0) = pack8(v0, v1); } break;
        case M_PART: { float* dst = (float*)o0 + ((size_t)(pb * 2048 + row) * 1024 + col0); *(f32x4*)dst = v0; *(f32x4*)(dst + 4) = v1; } break;
        }
    }
    __device__ __forceinline__ void operator()(const f32x4 (&acc)[2][2][4][2], const Unit& u, int wr, int wc, int fr, int fq) const {
        asm volatile("" : "+v"(fr), "+v"(fq));
        if constexpr (MODE == M_FA) {
            bf16_t* YC = (bf16_t*)o0; const int j = wr;
#pragma unroll
            for (int m = 0; m < 4; ++m) { const int k1 = 16 * m + fr, kq = k1 >> 2, jj = k1 & 3;
#pragma unroll
                for (int bj = 0; bj < 2; ++bj) { const int col0 = u.pn * BM + bj * HALF + wc * 32 + 8 * fq; const int tp0 = col0 & 31, mch = (col0 >> 5) & 1023, b = col0 >> 15;
                    f32x4 r0, r1, i0, i1;
#pragma unroll
                    for (int e = 0; e < 8; ++e) { const float yr = e < 4 ? acc[0][bj][m][0][e & 3] : acc[0][bj][m][1][e & 3], yi = e < 4 ? acc[1][bj][m][0][e & 3] : acc[1][bj][m][1][e & 3];
                        const float ph = (float)(k1 * (2 * (tp0 + e) + j)) * (6.283185307179586f / 4096.f); const float cs = __cosf(ph), sn = __sinf(ph);
                        const float orr = yr * cs + yi * sn, oi = yi * cs - yr * sn;
                        if (e < 4) { r0[e & 3] = orr; i0[e & 3] = oi; } else { r1[e & 3] = orr; i1[e & 3] = oi; } }
                    bf16_t* dst = YC + ((size_t)((b * 16 + kq) * 1024 + mch)) * 512 + jj * 128 + j * 32 + tp0;
                    *(u32x4*)dst = pack8(r0, r1); *(u32x4*)(dst + 64) = pack8(i0, i1); __builtin_amdgcn_sched_barrier(0); } }
        } else {
#pragma unroll
        for (int ai = 0; ai < 2; ++ai)
#pragma unroll
            for (int m = 0; m < 4; ++m) { const int row = u.pm * BM + ai * HALF + wr * 64 + m * 16 + fr;
#pragma unroll
                for (int bj = 0; bj < 2; ++bj) { const int col0 = u.pn * BM + bj * HALF + wc * 32 + 8 * fq; store8(u.pb, row, col0, acc[ai][bj][m][0], acc[ai][bj][m][1]); } }
        }
    }
};

template <int MODE> __device__ __forceinline__ void gemm_phase(LAS unsigned char* lds, const Gemm g, const Epi<MODE>& E, int G, int bid) {
    Order S; S.init(g, G, bid);
    const int tid = tid_opaque(), wid = __builtin_amdgcn_readfirstlane(tid >> 6), lane = tid & 63, wr = wid >> 2, wc = wid & 3, fr = lane & 15, fq = lane >> 4;
    int K = g.K; asm volatile("" : "+s"(K));
    const int nt = K / BK;
    unsigned voffA[2], voffB[2];
#pragma unroll
    for (int i = 0; i < 2; ++i) { int R, C; stage_rc(tid * 16 + i * 8192, R, C); const int Rb = (R & ~31) + perm32(R & 31);
        voffA[i] = (unsigned)(R * g.lda + C) * 2u; voffB[i] = (unsigned)(Rb * g.ldb + C) * 2u; }
    const size_t kstep = (size_t)(BK * 2);
    const size_t hstepA = (size_t)HALF * g.lda * 2, hstepB = (size_t)HALF * g.ldb * 2;
    const size_t tstepA = 2 * hstepA, tstepB = 2 * hstepB;
    const unsigned ldsw = (unsigned)wid * 1024u;
    const int aoff = lds_byte(wr * 64 + fr, fq * 8), boff = lds_byte(wc * 32 + fr, fq * 8);
#define PG8_SA(b, h) (((b) * 2 + (h)) * HTB)
#define PG8_SB(b, h) ((4 + (b) * 2 + (h)) * HTB)
#define PG8_STAGE(bufoff, gbase, voff) do { _Pragma("unroll") for (int _i = 0; _i < 2; ++_i) \
        __builtin_amdgcn_global_load_lds((const unsigned*)((const char*)(gbase) + (voff)[_i]), (LAS unsigned*)(lds + (bufoff) + ldsw + _i * 8192), 16, 0, 0); } while (0)
#define PG8_LDA(dst, b, h) do { _Pragma("unroll") for (int m = 0; m < 4; ++m) _Pragma("unroll") for (int k = 0; k < 2; ++k) dst[m][k] = *(const LAS bf16x8*)(lds + PG8_SA(b, h) + aoff + m * 2048 + k * 1024); } while (0)
#define PG8_LDB(dst, b, h) do { _Pragma("unroll") for (int n = 0; n < 2; ++n) _Pragma("unroll") for (int k = 0; k < 2; ++k) dst[n][k] = *(const LAS bf16x8*)(lds + PG8_SB(b, h) + boff + n * 2048 + k * 1024); } while (0)
#define PG8_MMA(ai, bj, At, Bt) do { __builtin_amdgcn_s_setprio(1); _Pragma("unroll") for (int m = 0; m < 4; ++m) _Pragma("unroll") for (int n = 0; n < 2; ++n) _Pragma("unroll") for (int k = 0; k < 2; ++k) \
        acc[ai][bj][m][n] = __builtin_amdgcn_mfma_f32_16x16x32_bf16(Bt[n][k], At[m][k], acc[ai][bj][m][n], 0, 0, 0); __builtin_amdgcn_s_setprio(0); } while (0)
#define PG8_WAIT_V(n) asm volatile("s_waitcnt vmcnt(" #n ")" ::: "memory")
#define PG8_WAIT_L(n) asm volatile("s_waitcnt lgkmcnt(" #n ")" ::: "memory")
#define PG8_BAR __builtin_amdgcn_s_barrier()
#define PG8_SCHED __builtin_amdgcn_sched_barrier(0)
    Unit cur, nxt; int ui = 0;
    if (!S.next(0, cur)) return;
    f32x4 acc[2][2][4][2];
#pragma unroll
    for (int a = 0; a < 2; ++a)
#pragma unroll
        for (int b = 0; b < 2; ++b)
#pragma unroll
            for (int m = 0; m < 4; ++m)
#pragma unroll
                for (int n = 0; n < 2; ++n) acc[a][b][m][n] = (f32x4){0.f, 0.f, 0.f, 0.f};
    bf16x8 At[4][2], B0[2][2], B1[2][2];
    const char* cA = (const char*)g.A + (size_t)cur.pb * g.sA * 2 + (size_t)cur.pm * tstepA;
    const char* cB = (const char*)g.Bt + (size_t)cur.pb * g.sB * 2 + (size_t)cur.pn * tstepB;
    PG8_STAGE(PG8_SB(0, 0), cB, voffB); PG8_STAGE(PG8_SB(0, 1), cB + hstepB, voffB); PG8_STAGE(PG8_SA(0, 0), cA, voffA); PG8_STAGE(PG8_SA(0, 1), cA + hstepA, voffA);
    if (wr == 1) PG8_BAR;
    PG8_WAIT_V(2); PG8_BAR;
    PG8_STAGE(PG8_SB(1, 0), cB + kstep, voffB); PG8_STAGE(PG8_SA(1, 0), cA + kstep, voffA); PG8_STAGE(PG8_SB(1, 1), cB + hstepB + kstep, voffB);
    PG8_WAIT_V(6); PG8_BAR;
    for (;;) {
        const bool has_next = S.next(ui + 1, nxt);
        const char* nA = has_next ? (const char*)g.A + (size_t)nxt.pb * g.sA * 2 + (size_t)nxt.pm * tstepA : cA;
        const char* nB = has_next ? (const char*)g.Bt + (size_t)nxt.pb * g.sB * 2 + (size_t)nxt.pn * tstepB : cB;
        for (int t = 0; t < nt; t += 2) {
            const bool last = (t == nt - 2);
            const char* a1 = cA + (size_t)(t + 1) * kstep;
            const char* a2 = last ? nA : cA + (size_t)(t + 2) * kstep; const char* b2 = last ? nB : cB + (size_t)(t + 2) * kstep;
            const char* a3 = a2 + kstep; const char* b3 = b2 + kstep;
            PG8_LDB(B0, 0, 0); PG8_LDB(B1, 0, 1); PG8_SCHED; PG8_LDA(At, 0, 0); PG8_STAGE(PG8_SA(1, 1), a1 + hstepA, voffA);
            PG8_WAIT_V(8); PG8_WAIT_L(0); PG8_BAR; PG8_MMA(0, 0, At, B0); PG8_MMA(0, 1, At, B1); PG8_BAR; PG8_SCHED;
            PG8_LDA(At, 0, 1); PG8_STAGE(PG8_SB(0, 0), b2, voffB); PG8_STAGE(PG8_SB(0, 1), b2 + hstepB, voffB); PG8_STAGE(PG8_SA(0, 0), a2, voffA);
            PG8_WAIT_V(8); PG8_WAIT_L(0); PG8_BAR; PG8_MMA(1, 0, At, B0); PG8_MMA(1, 1, At, B1); PG8_BAR; PG8_SCHED;
            PG8_LDB(B0, 1, 0); PG8_LDB(B1, 1, 1); PG8_SCHED; PG8_LDA(At, 1, 0); PG8_STAGE(PG8_SA(0, 1), a2 + hstepA, voffA);
            PG8_WAIT_V(8); PG8_WAIT_L(0); PG8_BAR; PG8_MMA(0, 0, At, B0); PG8_MMA(0, 1, At, B1); PG8_BAR; PG8_SCHED;
            PG8_LDA(At, 1, 1); PG8_STAGE(PG8_SB(1, 0), b3, voffB); PG8_STAGE(PG8_SB(1, 1), b3 + hstepB, voffB); PG8_STAGE(PG8_SA(1, 0), a3, voffA);
            PG8_WAIT_V(8); PG8_WAIT_L(0); PG8_BAR; PG8_MMA(1, 0, At, B0); PG8_MMA(1, 1, At, B1); PG8_BAR; PG8_SCHED;
        }
        if (wr == 0) PG8_BAR;
        E(acc, cur, wr, wc, fr, fq);
        if (!has_next) break;
#pragma unroll
        for (int a = 0; a < 2; ++a)
#pragma unroll
            for (int b = 0; b < 2; ++b)
#pragma unroll
                for (int m = 0; m < 4; ++m)
#pragma unroll
                    for (int n = 0; n < 2; ++n) acc[a][b][m][n] = (f32x4){0.f, 0.f, 0.f, 0.f};
        cur = nxt; cA = nA; cB = nB; ++ui;
        if (wr == 1) PG8_BAR;
    }
    PG8_WAIT_V(0);
    PG8_BAR;
#undef PG8_SA
#undef PG8_SB
#undef PG8_STAGE
#undef PG8_LDA
#undef PG8_LDB
#undef PG8_MMA
#undef PG8_WAIT_V
#undef PG8_WAIT_L
#undef PG8_BAR
#undef PG8_SCHED
}

struct TJob { const float* W; bf16_t* WT; int K, N, t; };
__device__ __forceinline__ void tjob_load(const TJob& j, int tid, f32x4 (&va)[4], f32x4 (&vb)[4]) {
    const int ntn = j.N / 64, kp = tid >> 4, n0 = (tid & 15) * 4;
#pragma unroll
    for (int q = 0; q < 4; ++q) { const int tile = j.t + q, tk = tile / ntn, tn = tile % ntn; const float* src = j.W + (size_t)(tk * 64 + 2 * kp) * j.N + tn * 64 + n0; va[q] = __builtin_nontemporal_load((const f32x4*)src); vb[q] = __builtin_nontemporal_load((const f32x4*)(src + j.N)); }
}
__device__ __forceinline__ void tjob_store(LAS unsigned char* lds, const TJob& j, int tid, const f32x4 (&va)[4], const f32x4 (&vb)[4]) {
    const int ntn = j.N / 64; LAS unsigned* t32 = (LAS unsigned*)lds;
    { const int kp = tid >> 4, n0 = (tid & 15) * 4;
#pragma unroll
      for (int q = 0; q < 4; ++q)
#pragma unroll
          for (int i = 0; i < 4; ++i) t32[q * 64 * 33 + (n0 + i) * 33 + kp] = cvt_pk_bf16(va[q][i], vb[q][i]); }
    __syncthreads();
    { const int n = tid >> 3, k0 = (tid & 7) * 8;
#pragma unroll
      for (int q = 0; q < 4; ++q) { const int tile = j.t + q, tk = tile / ntn, tn = tile % ntn; const LAS unsigned* r = t32 + q * 64 * 33 + n * 33 + (k0 >> 1);
          u32x4 v; v[0] = r[0]; v[1] = r[1]; v[2] = r[2]; v[3] = r[3];
          *(u32x4*)(j.WT + (size_t)(tn * 64 + n) * j.K + tk * 64 + k0) = v; } }
    __syncthreads();
}

constexpr int MOD_SC_OFF = 65536, MOD_RED_OFF = MOD_SC_OFF + 9 * 1024 * 4;
__device__ __forceinline__ void mod_stage(const Params& P, LAS unsigned char* lds) {
    const int tid = tid_opaque(); LAS float* sc = (LAS float*)(lds + MOD_SC_OFF);
    float v[18];
#pragma unroll
    for (int j = 0; j < 18; ++j) { const int i = tid + NTHR * j, bi = i >> 10, k = i & 1023; v[j] = bi < 8 ? P.c[bi * 1024 + k] : P.c_ctx[k]; }
#pragma unroll
    for (int j = 0; j < 18; ++j) sc[tid + NTHR * j] = v[j] * __builtin_amdgcn_rcpf(1.f + __expf(-v[j]));
    __syncthreads();
}
__device__ __forceinline__ void mod_unit(const Params& P, LAS unsigned char* lds, float* MOD, int u) {
    const int tid = tid_opaque(); const int L = u / 192, n0 = (u % 192) * 32;
    LAS float* sc = (LAS float*)(lds + MOD_SC_OFF);
    LAS float* red = (LAS float*)(lds + MOD_RED_OFF);
    const int col = tid & 31, kp = tid >> 5;
    float acc[9];
#pragma unroll
    for (int b = 0; b < 9; ++b) acc[b] = 0.f;
    const float* w = P.w_mod + (size_t)L * 1024 * 6144 + (size_t)(kp * 64) * 6144 + n0 + col;
#pragma unroll
    for (int h = 0; h < 2; ++h) { float wv[32];
#pragma unroll
        for (int j = 0; j < 32; ++j) wv[j] = __builtin_nontemporal_load(w + (size_t)(h * 32 + j) * 6144);
#pragma unroll
        for (int j = 0; j < 32; ++j) { const int k = kp * 64 + h * 32 + j;
#pragma unroll
            for (int b = 0; b < 9; ++b) acc[b] += sc[b * 1024 + k] * wv[j]; } }
#pragma unroll
    for (int b = 0; b < 9; ++b) red[(kp * 9 + b) * 32 + col] = acc[b];
    __syncthreads();
    if (tid < 288) { const int b = tid >> 5, cc = tid & 31; float sm = P.b_mod[L * 6144 + n0 + cc];
#pragma unroll
        for (int q = 0; q < 16; ++q) sm += red[(q * 9 + b) * 32 + cc];
        MOD[(size_t)(L * 9 + b) * 6144 + n0 + cc] = sm; }
    __syncthreads();
}

__device__ __forceinline__ void ktab_unit(const Params& P, LAS unsigned char* lds, float* KTAB, float* BBAR, float* APOW, int u) {
    const int tid = tid_opaque(); const int half = u & 1, gi = u >> 1, g = gi & 31, dir = (gi >> 5) & 1, e = gi >> 6;
    LAS float* ap = (LAS float*)lds;
    LAS float* Cm = ap + 33 * 128;
    LAS float* Bb = Cm + 2048;
    const int nl = half ? 33 : 32;
    for (int i = tid; i < nl * 64; i += NTHR) { const int ll = i >> 6, p = i & 63, l = 32 * half + ll; float ar, ai; apow(P, e, dir, g, p, (float)l, ar, ai); ap[2 * i] = ar; ap[2 * i + 1] = ai;
        APOW[((size_t)(gi * 65 + l) * 64 + p) * 2] = ar; APOW[((size_t)(gi * 65 + l) * 64 + p) * 2 + 1] = ai; }
    for (int i = tid; i < 1024; i += NTHR) { const int ho = i >> 6, p = i & 63; Cm[2 * i] = P.c_re[(size_t)(gi * 16 + ho) * 64 + p]; Cm[2 * i + 1] = P.c_im[(size_t)(gi * 16 + ho) * 64 + p]; }
    for (int i = tid; i < 1024; i += NTHR) { const int p = i >> 4, hi = i & 15; float ar, ai; apow(P, e, dir, g, p, 1.f, ar, ai);
        const float lr = fminf(P.lam_re[gi * 64 + p], -1e-4f), li = P.lam_im[gi * 64 + p], den = lr * lr + li * li, nr = ar - 1.f;
        const float fre = (nr * lr + ai * li) / den, fim = (ai * lr - nr * li) / den;
        const float br = P.b_re[(size_t)(gi * 64 + p) * 16 + hi], bi = P.b_im[(size_t)(gi * 64 + p) * 16 + hi];
        const float bbr = fre * br - fim * bi, bbi = fre * bi + fim * br;
        Bb[2 * i] = bbr; Bb[2 * i + 1] = bbi; if (half == 0) { BBAR[((size_t)gi * 1024 + i) * 2] = bbr; BBAR[((size_t)gi * 1024 + i) * 2 + 1] = bbi; } }
    __syncthreads();
    { const int ll = tid >> 4, ho = tid & 15, l = 32 * half + ll; float acc[16];
#pragma unroll
      for (int hi = 0; hi < 16; ++hi) acc[hi] = 0.f;
      for (int p = 0; p < 64; ++p) { const f32x2 cc = *(const LAS f32x2*)(Cm + (ho * 64 + p) * 2), aa = *(const LAS f32x2*)(ap + (ll * 64 + p) * 2);
          const float wr = cc[0] * aa[0] - cc[1] * aa[1], wi = cc[0] * aa[1] + cc[1] * aa[0];
#pragma unroll
          for (int h4 = 0; h4 < 8; ++h4) { const f32x4 bb = *(const LAS f32x4*)(Bb + p * 32 + h4 * 4); acc[2 * h4] += wr * bb[0] - wi * bb[1]; acc[2 * h4 + 1] += wr * bb[2] - wi * bb[3]; } }
      float* dst = KTAB + ((size_t)(gi * 64 + l)) * 256 + ho * 16;
#pragma unroll
      for (int h4 = 0; h4 < 4; ++h4) *(f32x4*)(dst + 4 * h4) = (f32x4){acc[4 * h4], acc[4 * h4 + 1], acc[4 * h4 + 2], acc[4 * h4 + 3]}; }
    __syncthreads();
}

__device__ __forceinline__ void phase0(const Params& P, LAS unsigned char* lds, int G, int bid) {
    unsigned char* ws = P.ws; const int tid = tid_opaque();
    const int NT_TOTAL = 2 * 512 + 2 * 256 + 2 * 64 + 2 * 256 + 4 * 1024 + 4 * 1024;
#define TJOB_DECODE(j, u4_) do { int t = (u4_) * 4; \
        if (t < 1024) { const int e = t / 512; t %= 512; j.W = P.w_in + (size_t)e * 1024 * 2048; j.WT = (bf16_t*)(ws + WS_WIN) + (size_t)e * 2048 * 1024; j.K = 1024; j.N = 2048; } \
        else if ((t -= 1024) < 512) { const int e = t / 256; t %= 256; j.W = P.w_out + (size_t)e * 1024 * 1024; j.WT = (bf16_t*)(ws + WS_WOUT) + (size_t)e * 1024 * 1024; j.K = 1024; j.N = 1024; } \
        else if ((t -= 512) < 128) { const int e = t / 64; t %= 64; j.W = P.w_glu + (size_t)e * 512 * 512; j.WT = (bf16_t*)(ws + WS_WGLU) + (size_t)e * 512 * 512; j.K = 512; j.N = 512; } \
        else if ((t -= 128) < 512) { const int e = t / 256; t %= 256; j.W = P.w_f + (size_t)e * 1024 * 1024; j.WT = (bf16_t*)(ws + WS_WF) + (size_t)e * 1024 * 1024; j.K = 1024; j.N = 1024; } \
        else if ((t -= 512) < 4096) { const int e = t / 1024; t %= 1024; j.W = P.w_ff1 + (size_t)e * 1024 * 4096; j.WT = (bf16_t*)P.out + (size_t)e * 4096 * 1024; j.K = 1024; j.N = 4096; } \
        else { t -= 4096; const int e = t / 1024; t %= 1024; j.W = P.w_ff2 + (size_t)e * 4096 * 1024; j.WT = (bf16_t*)P.out + (size_t)4 * 4096 * 1024 + (size_t)e * 1024 * 4096; j.K = 4096; j.N = 1024; } \
        j.t = t; } while (0)
    { f32x4 va[4], vb[4]; TJob cur; cur.W = nullptr; cur.WT = nullptr; cur.K = 0; cur.N = 64; cur.t = 0;
      int u4 = bid;
      if (u4 < NT_TOTAL / 4) { TJOB_DECODE(cur, u4); tjob_load(cur, tid, va, vb); }
      while (u4 < NT_TOTAL / 4) {
          f32x4 wa[4], wb[4];
#pragma unroll
          for (int q = 0; q < 4; ++q) { wa[q] = va[q]; wb[q] = vb[q]; }
          const TJob now = cur; const int nu = u4 + G;
          if (nu < NT_TOTAL / 4) { TJOB_DECODE(cur, nu); tjob_load(cur, tid, va, vb); }
          tjob_store(lds, now, tid, wa, wb);
          u4 = nu;
      } }
#undef TJOB_DECODE
    mod_stage(P, lds);
    for (int u = bid; u < 768; u += G) mod_unit(P, lds, (float*)(ws + WS_MOD), u);
    for (int u = bid; u < 256; u += G) ktab_unit(P, lds, (float*)(ws + WS_KTAB), (float*)(ws + WS_BBAR), (float*)(ws + WS_APOW), u);
    const size_t gtid = (size_t)bid * NTHR + tid, gn = (size_t)G * NTHR;
    { bf16_t* T = (bf16_t*)(ws + WS_CDSD);
      for (size_t i = gtid; i < (size_t)1024 * 1024 / 2; i += gn) { const int row = (int)(i >> 9), d0 = (int)(i & 511) * 2; const bool isSin = row >= 513; const int m = isSin ? row - 512 : row; float v[2];
#pragma unroll
          for (int j = 0; j < 2; ++j) { const float ang = (float)((m * (d0 + j)) & 1023) * (6.283185307179586f / 1024.f); v[j] = isSin ? sinf(ang) : cosf(ang); }
          *(unsigned*)(T + (size_t)row * 1024 + d0) = cvt_pk_bf16(v[0], v[1]); } }
    { bf16_t* T = (bf16_t*)(ws + WS_DA);
      for (size_t i = gtid; i < (size_t)256 * 256; i += gn) { const int row = (int)(i >> 8), col = (int)(i & 255); const int c = row >> 7, j = (row >> 6) & 1, k1 = row & 63, j2 = col >> 7, c2 = (col >> 6) & 1, t1 = col & 63;
          const float ang = (float)((k1 * t1) & 63) * (6.283185307179586f / 64.f); float v = 0.f;
          if (j == j2) v = (c == 0) ? (c2 == 0 ? cosf(ang) : -sinf(ang)) : (c2 == 0 ? -sinf(ang) : -cosf(ang));
          T[i] = f2bf(v); } }
    { bf16_t* T = (bf16_t*)(ws + WS_DC);
      for (size_t i = gtid; i < (size_t)256 * 512; i += gn) { const int row = (int)(i >> 9), col = (int)(i & 511); const int jj = row >> 6, k2 = row & 63, jj2 = col >> 7, c = (col >> 6) & 1, j = (col >> 5) & 1, tp = col & 31, t2 = 2 * tp + j;
          const float ang = (float)((k2 * t2) & 63) * (6.283185307179586f / 64.f); float v = 0.f;
          if (jj == jj2) v = c == 0 ? cosf(ang) : sinf(ang);
          T[i] = f2bf(v); } }
    { bf16_t* T = (bf16_t*)(ws + WS_AL256);
      for (size_t i = gtid; i < (size_t)256 * 512 / 2; i += gn) { const int k = (int)(i >> 8), c0 = (int)(i & 255) * 2; float v[2];
#pragma unroll
          for (int j = 0; j < 2; ++j) { const int cc = c0 + j, t = cc & 255; const float ang = (float)((k * t) & 255) * (6.283185307179586f / 256.f); v[j] = cc < 256 ? cosf(ang) : -sinf(ang); }
          *(unsigned*)(T + (size_t)k * 512 + c0) = cvt_pk_bf16(v[0], v[1]); } }
}

struct RowArgs {
    const float* hin_lat; const float* hin_ctx; float* hout_lat; float* hout_ctx;
    const bf16_t* R; const float* modA; int gate_off; const float* gainA;
    bf16_t* A; const float* modB; int shift_off, scale_off; const float* gainB;
    int nrows; int perm; const float* part; const bf16_t* hin_bf; bf16_t* hout_bf;
};
template <int RP, bool HINBF, bool HOUTBF> __device__ __forceinline__ void rows_seq(const RowArgs& a, int row0, int n, int bi, int lane) {
    const bool lat = row0 < TL;
    const float* hin = lat ? a.hin_lat + (size_t)row0 * D : a.hin_ctx + (size_t)(row0 - TL) * D;
    float* hout = lat ? a.hout_lat + (size_t)row0 * D : a.hout_ctx + (size_t)(row0 - TL) * D;
    const bf16_t* hinb = a.hin_bf + (size_t)row0 * D; bf16_t* houtb = a.hout_bf + (size_t)row0 * D;
    const bool hasR = a.R != nullptr, hasA = a.A != nullptr;
    const bf16_t* Rp = a.R + (size_t)row0 * D;
    f32x4 gg[4], gs[4], sh[4];
#pragma unroll
    for (int q = 0; q < 4; ++q) { const int col = 4 * lane + 256 * q;
        if (hasR) gg[q] = *(const f32x4*)(a.modA + (size_t)bi * 6144 + a.gate_off + col) * *(const f32x4*)(a.gainA + col);
        if (hasA) { gs[q] = *(const f32x4*)(a.gainB + col) * (*(const f32x4*)(a.modB + (size_t)bi * 6144 + a.scale_off + col) + 1.f); sh[q] = *(const f32x4*)(a.modB + (size_t)bi * 6144 + a.shift_off + col); } }
    f32x4 nh[RP][4]; u32x2 nhb[RP][4]; u32x2 nr[RP][4];
#define ROW_LOAD(i0) do { _Pragma("unroll") for (int r = 0; r < RP; ++r) _Pragma("unroll") for (int q = 0; q < 4; ++q) { \
        if (HINBF) nhb[r][q] = __builtin_nontemporal_load((const u32x2*)(hinb + (size_t)((i0) + r) * D + 4 * lane + 256 * q)); else nh[r][q] = __builtin_nontemporal_load((const f32x4*)(hin + (size_t)((i0) + r) * D + 4 * lane + 256 * q)); \
        if (hasR && lat) nr[r][q] = __builtin_nontemporal_load((const u32x2*)(Rp + (size_t)((i0) + r) * D + 4 * lane + 256 * q)); } } while (0)
    ROW_LOAD(0);
    for (int i = 0; i < n; i += RP) {
        f32x4 hv[RP][4]; u32x2 rw[RP][4];
#pragma unroll
        for (int r = 0; r < RP; ++r)
#pragma unroll
            for (int q = 0; q < 4; ++q) { if (HINBF) { hv[r][q][0] = bflo(nhb[r][q][0]); hv[r][q][1] = bfhi(nhb[r][q][0]); hv[r][q][2] = bflo(nhb[r][q][1]); hv[r][q][3] = bfhi(nhb[r][q][1]); } else hv[r][q] = nh[r][q]; rw[r][q] = nr[r][q]; }
        if (i + RP < n) ROW_LOAD(i + RP);
#pragma unroll
        for (int r = 0; r < RP; ++r) {
            if (hasR) {
                f32x4 rv[4]; float ss = 0.f;
#pragma unroll
                for (int q = 0; q < 4; ++q) {
                    if (lat) { rv[q][0] = bflo(rw[r][q][0]); rv[q][1] = bfhi(rw[r][q][0]); rv[q][2] = bflo(rw[r][q][1]); rv[q][3] = bfhi(rw[r][q][1]); }
                    else { const float* pp = a.part + (size_t)(row0 - TL + i + r) * 1024 + 4 * lane + 256 * q;
                        rv[q] = *(const f32x4*)pp + *(const f32x4*)(pp + (size_t)2048 * 1024) + *(const f32x4*)(pp + (size_t)2 * 2048 * 1024) + *(const f32x4*)(pp + (size_t)3 * 2048 * 1024); }
                    ss += rv[q][0] * rv[q][0] + rv[q][1] * rv[q][1] + rv[q][2] * rv[q][2] + rv[q][3] * rv[q][3]; }
                ss = wave_sum(ss); const float rinv = rsqrtf(ss * (1.f / 1024.f) + 1e-6f);
#pragma unroll
                for (int q = 0; q < 4; ++q) hv[r][q] += gg[q] * (rv[q] * rinv);
            }
            if (HOUTBF) {
#pragma unroll
                for (int q = 0; q < 4; ++q) { u32x2 o; o[0] = cvt_pk_bf16(hv[r][q][0], hv[r][q][1]); o[1] = cvt_pk_bf16(hv[r][q][2], hv[r][q][3]); __builtin_nontemporal_store(o, (u32x2*)(houtb + (size_t)(i + r) * D + 4 * lane + 256 * q)); }
            } else if (hasR) {
#pragma unroll
                for (int q = 0; q < 4; ++q) __builtin_nontemporal_store(hv[r][q], (f32x4*)(hout + (size_t)(i + r) * D + 4 * lane + 256 * q));
            }
            if (hasA) {
                float ss = 0.f;
#pragma unroll
                for (int q = 0; q < 4; ++q) ss += hv[r][q][0] * hv[r][q][0] + hv[r][q][1] * hv[r][q][1] + hv[r][q][2] * hv[r][q][2] + hv[r][q][3] * hv[r][q][3];
                ss = wave_sum(ss); const float rinv = rsqrtf(ss * (1.f / 1024.f) + 1e-6f);
#pragma unroll
                for (int q = 0; q < 4; ++q) { const f32x4 y = (hv[r][q] * rinv) * gs[q] + sh[q];
                    u32x2 o; o[0] = cvt_pk_bf16(y[0], y[1]); o[1] = cvt_pk_bf16(y[2], y[3]);
                    const int rr = row0 + i + r; const size_t arow = (lat && a.perm) ? (size_t)((rr & ~4095) | ((rr & 63) << 6) | ((rr >> 6) & 63)) : (size_t)rr;
                    *(u32x2*)(a.A + arow * D + 4 * lane + 256 * q) = o; }
            }
        }
    }
#undef ROW_LOAD
}
template <int MODE> __device__ __forceinline__ void row_phase(const RowArgs& a, int G, int bid) {
    const int tid = tid_opaque(), lane = tid & 63, wave = tid >> 6; const int gw = bid * 8 + wave, nw = G * 8;
    for (int c = gw; c < TL / 16; c += nw) rows_seq<2, (MODE >= 2), (MODE == 1 || MODE == 2)>(a, c * 16, 16, (c * 16) >> 12, lane);
    if (a.nrows > TL) for (int r = gw; r < TC; r += nw) rows_seq<1, false, false>(a, TL + r, 1, 8, lane);
}

__device__ __forceinline__ void build_s5(const Params& P, int e, int G, int bid) {
    unsigned char* ws = P.ws; const float* KT = (const float*)(ws + WS_KTAB); const float* BB = (const float*)(ws + WS_BBAR);
    bf16_t* MG = (bf16_t*)(ws + WS_BIG + BG_MG); bf16_t* WST = (bf16_t*)(ws + WS_BIG + BG_WST); const float* AP = (const float*)(ws + WS_APOW);
    const size_t gtid = (size_t)bid * NTHR + tid_opaque(), gn = (size_t)G * NTHR;
#pragma unroll 4
    for (size_t it = gtid; it < (size_t)32 * 1024 * 128; it += gn) {
        const int k8 = (int)(it & 127), n = (int)((it >> 7) & 1023), g = (int)(it >> 17);
        const int i = n >> 4, ho = n & 15, j = k8 >> 1, hi0 = (k8 & 1) * 8;
        const int dir = i >= j ? 0 : 1, l = i >= j ? i - j : j - i; const bool dg = i == j;
        const float* src = KT + ((size_t)((e * 2 + dir) * 32 + g) * 64 + l) * 256 + ho * 16 + hi0;
        const float* s1 = KT + ((size_t)((e * 2 + 1) * 32 + g) * 64) * 256 + ho * 16 + hi0;
        const f32x4 x0 = *(const f32x4*)src, x1 = *(const f32x4*)(src + 4);
        f32x4 y0 = {0.f, 0.f, 0.f, 0.f}, y1 = {0.f, 0.f, 0.f, 0.f}; float dv = 0.f;
        if (dg) { y0 = *(const f32x4*)s1; y1 = *(const f32x4*)(s1 + 4); dv = P.s5_d[e * 512 + g * 16 + ho]; }
        f32x4 v0 = x0 + y0, v1 = x1 + y1;
        if (dg) { if (ho < 8) { if (hi0 == 0) v0[ho & 3] += (ho < 4) ? dv : 0.f, v1[ho & 3] += (ho >= 4) ? dv : 0.f; } else { if (hi0 == 8) v0[ho & 3] += (ho < 12) ? dv : 0.f, v1[ho & 3] += (ho >= 12) ? dv : 0.f; } }
        *(u32x4*)(MG + ((size_t)(g * 1024 + n)) * ULD + k8 * 8) = pack8(v0, v1);
    }
#pragma unroll 2
    for (size_t it = gtid; it < (size_t)32 * 1024 * 32; it += gn) {
        const int k8 = 128 + (int)(it & 31), n = (int)((it >> 5) & 1023), g = (int)(it >> 15);
        const int i = n >> 4, ho = n & 15; float v[8];
        { const int kk0 = (k8 - 128) * 8, dir = kk0 >> 7, p0 = (kk0 & 127) >> 1; const int pw = dir == 0 ? (i + 1) : (64 - i);
            const int gi = (e * 2 + dir) * 32 + g;
            const f32x4 a01 = *(const f32x4*)(AP + ((size_t)(gi * 65 + pw) * 64 + p0) * 2), a23 = *(const f32x4*)(AP + ((size_t)(gi * 65 + pw) * 64 + p0) * 2 + 4);
            const f32x4 cr = *(const f32x4*)(P.c_re + (size_t)(gi * 16 + ho) * 64 + p0), ci = *(const f32x4*)(P.c_im + (size_t)(gi * 16 + ho) * 64 + p0);
            v[0] = cr[0] * a01[0] - ci[0] * a01[1]; v[1] = -(cr[0] * a01[1] + ci[0] * a01[0]);
            v[2] = cr[1] * a01[2] - ci[1] * a01[3]; v[3] = -(cr[1] * a01[3] + ci[1] * a01[2]);
            v[4] = cr[2] * a23[0] - ci[2] * a23[1]; v[5] = -(cr[2] * a23[1] + ci[2] * a23[0]);
            v[6] = cr[3] * a23[2] - ci[3] * a23[3]; v[7] = -(cr[3] * a23[3] + ci[3] * a23[2]); }
        u32x4 o; o[0] = cvt_pk_bf16(v[0], v[1]); o[1] = cvt_pk_bf16(v[2], v[3]); o[2] = cvt_pk_bf16(v[4], v[5]); o[3] = cvt_pk_bf16(v[6], v[7]);
        *(u32x4*)(MG + ((size_t)(g * 1024 + n)) * ULD + k8 * 8) = o;
    }
#pragma unroll 4
    for (size_t it = gtid; it < (size_t)32 * 256 * 128; it += gn) {
        const int k8 = (int)(it & 127), n = (int)((it >> 7) & 255), g = (int)(it >> 15);
        const int dir = n >> 7, p = (n & 127) >> 1, c = n & 1, j = k8 >> 1, hi0 = (k8 & 1) * 8; const int gi = (e * 2 + dir) * 32 + g;
        const f32x2 aa = *(const f32x2*)(AP + ((size_t)(gi * 65 + (dir == 0 ? 63 - j : j)) * 64 + p) * 2); const float ar = aa[0], ai = aa[1];
        const float* bb = BB + ((size_t)gi * 1024 + p * 16 + hi0) * 2; float v[8];
#pragma unroll
        for (int q = 0; q < 8; ++q) { const float br = bb[2 * q], bi = bb[2 * q + 1]; v[q] = c == 0 ? (ar * br - ai * bi) : (ar * bi + ai * br); }
        u32x4 o; o[0] = cvt_pk_bf16(v[0], v[1]); o[1] = cvt_pk_bf16(v[2], v[3]); o[2] = cvt_pk_bf16(v[4], v[5]); o[3] = cvt_pk_bf16(v[6], v[7]);
        *(u32x4*)(WST + ((size_t)(g * 256 + n)) * 1024 + k8 * 8) = o;
    }
}

__device__ __forceinline__ void carry_phase(const Params& P, int e, int G, int bid) {
    unsigned char* ws = P.ws; bf16_t* U = (bf16_t*)(ws + WS_BIG + BG_U); const float* SL = (const float*)(ws + WS_BIG + BG_SLOC); const float* AP = (const float*)(ws + WS_APOW);
    const int tid = tid_opaque(), lane = tid & 63, wave = tid >> 6;
    for (int wt = wave * G + bid; wt < 512; wt += 8 * G) {
        const int dir = wt & 1, g = (wt >> 1) & 31, b = wt >> 6, p = lane; const int gi = (e * 2 + dir) * 32 + g;
        const f32x2 aa = *(const f32x2*)(AP + ((size_t)(gi * 65 + 64) * 64 + p) * 2); const float ar = aa[0], ai = aa[1];
        float sr = 0.f, si = 0.f;
        for (int s17 = 0; s17 < 4; ++s17) {
            f32x2 sl[17];
#pragma unroll
            for (int q = 0; q < 17; ++q) { const int step = s17 * 17 + q; const int row = step < 4 ? 512 + 4 * b + (dir ? 3 - step : step) : 64 * b + (dir ? 63 - (step - 4) : step - 4);
                sl[q] = *(const f32x2*)(SL + ((size_t)(g * UROWS + row) * 256 + dir * 128 + 2 * p)); }
#pragma unroll
            for (int q = 0; q < 17; ++q) { const int step = s17 * 17 + q; const int row = step < 4 ? 512 + 4 * b + (dir ? 3 - step : step) : 64 * b + (dir ? 63 - (step - 4) : step - 4);
                *(unsigned*)(U + ((size_t)(g * UROWS + row) * ULD + 1024 + dir * 128 + 2 * p)) = cvt_pk_bf16(sr, si);
                const float nr = ar * sr - ai * si + sl[q][0], ni = ar * si + ai * sr + sl[q][1]; sr = nr; si = ni; }
        }
    }
}

template <int NB> struct NaS { f32x4 v[2][NB]; };
__device__ __forceinline__ void na_unit_dummy() {}
__device__ __forceinline__ void na_phase(const Params& P, LAS unsigned char* lds, int e, bool ctx_out, int G, int bid) {
    unsigned char* ws = P.ws; const bf16_t* QK = (const bf16_t*)(ws + WS_BIG + BG_QKV); const bf16_t* VT = QK + (size_t)TT * 1024; bf16_t* MO = (bf16_t*)(ws + WS_ABUF);
    const float* rpb = P.rpb + (size_t)e * 8 * 15 * 31;
    const int tid = tid_opaque(), lane = tid & 63, wave = tid >> 6, hs = wave >> 2, w4 = wave & 3, lq = lane & 15, lg = lane >> 4;
    constexpr int KBUF = 2 * 64 * 72 * 2;
    constexpr int TILE_B = 2 * KBUF;
    constexpr int RPB_OFF = 2 * TILE_B;
    LAS float* rpbs = (LAS float*)(lds + RPB_OFF);
    for (int i = tid; i < 8 * 15 * 31; i += NTHR) rpbs[i] = rpb[i] * 1.4426950408889634f;
#define KKEY(i) ((tid >> 4) + 32 * (i))
#define KHSL(i) ((tid >> 3) & 1)
#define KD0(i)  ((tid & 7) * 8)
#define VHSL(i) (i)
#define VDV(i)  ((tid >> 3) & 63)
#define VK8(i)  (tid & 7)
    const int koff = min(max(16 * w4 - 8, 0), 32);
    const int qc = 16 * w4 + lq, c0 = min(max(qc - 8, 0), 48);
    const int nlu = (1024 - bid + G - 1) / G, vb = (bid + G - 32) % G, ncu = (ctx_out && vb < 64) ? (64 - vb + G - 1) / G : 0;
    for (int it = 0; it < nlu + ncu; ++it) {
        const int u = it < nlu ? bid + it * G : 1024 + vb + (it - nlu) * G;
        int b, hp, qtokA, qtokB, r = 0, ra0 = 0, dlt = 0, npair; const bool islat = u < 1024;
        if (islat) { b = u >> 7; r = ((u >> 2) & 31) * 2; hp = u & 3; qtokA = b * 4096 + r * 64; qtokB = qtokA + 64; ra0 = min(max(r - 4, 0), 56); dlt = min(max(r - 3, 0), 56) - ra0; npair = 7; }
        else { const int v = u - 1024; b = v >> 3; const int qb2 = (v >> 2) & 1; hp = v & 3; qtokA = TL + b * 256 + qb2 * 128; qtokB = qtokA + 64; npair = 2; }
        const int head = 2 * hp + hs;
        bf16x8 qf[2][2];
        { const bf16_t* qpA = QK + (size_t)(qtokA + 16 * w4 + lq) * 1024 + head * 64 + 8 * lg; const bf16_t* qpB = QK + (size_t)(qtokB + 16 * w4 + lq) * 1024 + head * 64 + 8 * lg;
          qf[0][0] = *(const bf16x8*)qpA; qf[0][1] = *(const bf16x8*)(qpA + 32); qf[1][0] = *(const bf16x8*)qpB; qf[1][1] = *(const bf16x8*)(qpB + 32); }
        f32x4 O[2][4];
#pragma unroll
        for (int g2 = 0; g2 < 2; ++g2)
#pragma unroll
            for (int i = 0; i < 4; ++i) O[g2][i] = (f32x4){0.f, 0.f, 0.f, 0.f};
        float mrun[2] = {-1e30f, -1e30f}, lrun[2] = {0.f, 0.f};
        u32x4 kreg[2][2], vreg[2][2];
#define NA_KTOK(t) (islat ? ((t) < 10 ? b * 4096 + min(ra0 + (t), 63) * 64 : TL + b * 256 + ((t) - 10) * 64) : TL + b * 256 + (t) * 64)
#define NA_LOAD(pr) do { _Pragma("unroll") for (int s_ = 0; s_ < 2; ++s_) { const int _kt = NA_KTOK(2 * (pr) + s_); _Pragma("unroll") for (int i = 0; i < 2; ++i) { \
            kreg[s_][i] = *(const u32x4*)(QK + (size_t)(_kt + KKEY(i)) * 1024 + 512 + (2 * hp + KHSL(i)) * 64 + KD0(i)); \
            vreg[s_][i] = *(const u32x4*)(VT + (size_t)((2 * hp + VHSL(i)) * 64 + VDV(i)) * TT + _kt + VK8(i) * 8); } } } while (0)
#define NA_WRITE() do { _Pragma("unroll") for (int s_ = 0; s_ < 2; ++s_) _Pragma("unroll") for (int i = 0; i < 2; ++i) { \
            *(LAS u32x4*)(lds + s_ * TILE_B + ((KHSL(i) * 64 + KKEY(i)) * 72 + KD0(i)) * 2) = kreg[s_][i]; \
            *(LAS u32x4*)(lds + s_ * TILE_B + KBUF + ((VHSL(i) * 64 + VDV(i)) * 72 + VK8(i) * 8) * 2) = vreg[s_][i]; } } while (0)
        NA_LOAD(0);
        for (int pr = 0; pr < npair; ++pr) {
            __syncthreads();
            NA_WRITE();
            __syncthreads();
            if (pr + 1 < npair) NA_LOAD(pr + 1);
            if (islat && pr < 5) {
#pragma unroll
                for (int g2 = 0; g2 < 2; ++g2) {
                    const int t0 = 2 * pr, lo = g2 ? dlt : 0, hi = lo + 7;
                    const bool act0 = (t0 >= lo) && (t0 <= hi), act1 = (t0 + 1 >= lo) && (t0 + 1 <= hi);
                    if (act0 || act1) {
                        f32x4 S[2][2];
#pragma unroll
                        for (int s_ = 0; s_ < 2; ++s_) { const bool act = s_ ? act1 : act0; const int dr = (ra0 + t0 + s_) - (r + g2) + 7; const LAS float* bp = rpbs + (head * 15 + min(max(dr, 0), 14)) * 31;
#pragma unroll
                            for (int kb = 0; kb < 2; ++kb) { S[s_][kb] = (f32x4){0.f, 0.f, 0.f, 0.f};
                                const LAS unsigned char* ka = lds + s_ * TILE_B + ((hs * 64 + koff + 16 * kb + lq) * 72 + 8 * lg) * 2;
                                const bf16x8 a0 = *(const LAS bf16x8*)ka, a1 = *(const LAS bf16x8*)(ka + 64);
                                S[s_][kb] = __builtin_amdgcn_mfma_f32_16x16x32_bf16(a0, qf[g2][0], S[s_][kb], 0, 0, 0);
                                S[s_][kb] = __builtin_amdgcn_mfma_f32_16x16x32_bf16(a1, qf[g2][1], S[s_][kb], 0, 0, 0);
#pragma unroll
                                for (int v = 0; v < 4; ++v) { const int kc = koff + 16 * kb + 4 * lg + v; const bool ok = act && ((unsigned)(kc - c0) < 16u);
                                    S[s_][kb][v] = ok ? S[s_][kb][v] + bp[kc - qc + 15] : -1e30f; } } }
                        float tmax = -1e30f;
#pragma unroll
                        for (int s_ = 0; s_ < 2; ++s_)
#pragma unroll
                            for (int kb = 0; kb < 2; ++kb)
#pragma unroll
                                for (int v = 0; v < 4; ++v) tmax = fmaxf(tmax, S[s_][kb][v]);
                        tmax = fmaxf(tmax, __shfl_xor(tmax, 16)); tmax = fmaxf(tmax, __shfl_xor(tmax, 32));
                        const float mnew = fmaxf(mrun[g2], tmax), alpha = __builtin_amdgcn_exp2f(mrun[g2] - mnew); mrun[g2] = mnew;
                        float lsum = 0.f;
#pragma unroll
                        for (int s_ = 0; s_ < 2; ++s_)
#pragma unroll
                            for (int kb = 0; kb < 2; ++kb)
#pragma unroll
                                for (int v = 0; v < 4; ++v) { const float pv = __builtin_amdgcn_exp2f(S[s_][kb][v] - mnew); S[s_][kb][v] = pv; lsum += pv; }
                        lrun[g2] = lrun[g2] * alpha + lsum;
#pragma unroll
                        for (int i = 0; i < 4; ++i) O[g2][i] *= alpha;
#pragma unroll
                        for (int s_ = 0; s_ < 2; ++s_) { const u32x4 pk = pack8(S[s_][0], S[s_][1]); const bf16x8 pbv = __builtin_bit_cast(bf16x8, pk);
#pragma unroll
                            for (int dvb = 0; dvb < 4; ++dvb) { const LAS unsigned char* va = lds + s_ * TILE_B + KBUF + ((hs * 64 + 16 * dvb + lq) * 72 + koff + 4 * lg) * 2;
                                const u32x2 x0 = *(const LAS u32x2*)va, x1 = *(const LAS u32x2*)(va + 32); u32x4 av; av[0] = x0[0]; av[1] = x0[1]; av[2] = x1[0]; av[3] = x1[1];
                                O[g2][dvb] = __builtin_amdgcn_mfma_f32_16x16x32_bf16(__builtin_bit_cast(bf16x8, av), pbv, O[g2][dvb], 0, 0, 0); } }
                    }
                }
            } else {
#pragma unroll
                for (int s_ = 0; s_ < 2; ++s_) {
                    f32x4 S[2][4];
#pragma unroll
                    for (int kb = 0; kb < 4; ++kb) {
                        const LAS unsigned char* ka = lds + s_ * TILE_B + ((hs * 64 + 16 * kb + lq) * 72 + 8 * lg) * 2;
                        const bf16x8 a0 = *(const LAS bf16x8*)ka, a1 = *(const LAS bf16x8*)(ka + 64);
#pragma unroll
                        for (int g2 = 0; g2 < 2; ++g2) { S[g2][kb] = (f32x4){0.f, 0.f, 0.f, 0.f};
                            S[g2][kb] = __builtin_amdgcn_mfma_f32_16x16x32_bf16(a0, qf[g2][0], S[g2][kb], 0, 0, 0);
                            S[g2][kb] = __builtin_amdgcn_mfma_f32_16x16x32_bf16(a1, qf[g2][1], S[g2][kb], 0, 0, 0); } }
#pragma unroll
                    for (int g2 = 0; g2 < 2; ++g2) {
                        float tmax = -1e30f;
#pragma unroll
                        for (int kb = 0; kb < 4; ++kb)
#pragma unroll
                            for (int v = 0; v < 4; ++v) tmax = fmaxf(tmax, S[g2][kb][v]);
                        tmax = fmaxf(tmax, __shfl_xor(tmax, 16)); tmax = fmaxf(tmax, __shfl_xor(tmax, 32));
                        const float mnew = fmaxf(mrun[g2], tmax), alpha = __builtin_amdgcn_exp2f(mrun[g2] - mnew); mrun[g2] = mnew;
                        float lsum = 0.f;
#pragma unroll
                        for (int kb = 0; kb < 4; ++kb)
#pragma unroll
                            for (int v = 0; v < 4; ++v) { const float pv = __builtin_amdgcn_exp2f(S[g2][kb][v] - mnew); S[g2][kb][v] = pv; lsum += pv; }
                        lrun[g2] = lrun[g2] * alpha + lsum;
#pragma unroll
                        for (int i = 0; i < 4; ++i) O[g2][i] *= alpha;
#pragma unroll
                        for (int kk = 0; kk < 2; ++kk) { const u32x4 pk = pack8(S[g2][2 * kk], S[g2][2 * kk + 1]); const bf16x8 pbv = __builtin_bit_cast(bf16x8, pk);
#pragma unroll
                            for (int dvb = 0; dvb < 4; ++dvb) { const LAS unsigned char* va = lds + s_ * TILE_B + KBUF + ((hs * 64 + 16 * dvb + lq) * 72 + 32 * kk + 4 * lg) * 2;
                                const u32x2 x0 = *(const LAS u32x2*)va, x1 = *(const LAS u32x2*)(va + 32); u32x4 av; av[0] = x0[0]; av[1] = x0[1]; av[2] = x1[0]; av[3] = x1[1];
                                O[g2][dvb] = __builtin_amdgcn_mfma_f32_16x16x32_bf16(__builtin_bit_cast(bf16x8, av), pbv, O[g2][dvb], 0, 0, 0); } }
                    }
                }
            }
        }
#undef NA_KTOK
#undef NA_LOAD
#undef NA_WRITE
#pragma unroll
        for (int g2 = 0; g2 < 2; ++g2) {
            float lr = lrun[g2]; lr += __shfl_xor(lr, 16); lr += __shfl_xor(lr, 32);
            const float inv = 1.f / lr;
            bf16_t* op = MO + (size_t)((g2 ? qtokB : qtokA) + 16 * w4 + lq) * 1024 + 512 + head * 64 + 4 * lg;
#pragma unroll
            for (int dvb = 0; dvb < 4; ++dvb) { u32x2 o; o[0] = cvt_pk_bf16(O[g2][dvb][0] * inv, O[g2][dvb][1] * inv); o[1] = cvt_pk_bf16(O[g2][dvb][2] * inv, O[g2][dvb][3] * inv); *(u32x2*)(op + 16 * dvb) = o; }
        }
    }
    __syncthreads();
}

#define XB_TMO      128
#define XB_XCNT(j)  (256  + 64 * (j))
#define XB_XSUB(j)  (1280 + 64 * (j))
#define XB_XGEN(j)  (2304 + 64 * (j))
#define XB_TOP      3328
#define XB_TOPGEN   3392
#define XCD_BAR_WORDS 3456
#define XB_SPIN_CAP (1u << 18)
__device__ __forceinline__ unsigned xb_ld(unsigned* p)              { return __hip_atomic_load(p, __ATOMIC_RELAXED, __HIP_MEMORY_SCOPE_AGENT); }
__device__ __forceinline__ unsigned xb_add(unsigned* p, unsigned v) { return __hip_atomic_fetch_add(p, v, __ATOMIC_RELAXED, __HIP_MEMORY_SCOPE_AGENT); }
__device__ __forceinline__ unsigned xb_xcc_id() { return (unsigned)__builtin_amdgcn_s_getreg((3 << 11) | 20) & 0xFu; }
#define XB_SPIN(cond, bar) do { unsigned _sp = 0; while (cond) { __builtin_amdgcn_s_sleep(1); \
    if ((++_sp & 255u) == 0u) { if (xb_ld(&(bar)[XB_TMO])) break; if (_sp > XB_SPIN_CAP) { atomicAdd(&(bar)[XB_TMO], 1u); break; } } } } while (0)
struct XcdBarrier { unsigned* bar; unsigned x; volatile LAS unsigned* st; };
__device__ __forceinline__ XcdBarrier xcd_barrier_post(unsigned* bar, volatile LAS unsigned* st) {
    XcdBarrier b; b.bar = bar; b.x = xb_xcc_id(); b.st = st;
    if (threadIdx.x == 0) (void)xb_add(&bar[XB_XCNT(b.x)], 1u);
    return b;
}
__device__ __forceinline__ void xcd_barrier_complete(unsigned* bar, unsigned x, unsigned& nloc, unsigned& nx) {
    const unsigned G = gridDim.x * gridDim.y * gridDim.z;
    unsigned sum, cnt, mine, sp = 0u;
    for (;;) {
        sum = 0u; cnt = 0u; mine = 0u;
#pragma unroll
        for (unsigned j = 0; j < 16; ++j) { const unsigned c = xb_ld(&bar[XB_XCNT(j)]); sum += c; cnt += (c > 0u) ? 1u : 0u; mine = (j == x) ? c : mine; }
        if (sum == G) break;
        __builtin_amdgcn_s_sleep(1);
        if ((++sp & 255u) == 0u) { if (xb_ld(&bar[XB_TMO])) break; if (sp > XB_SPIN_CAP) { atomicAdd(&bar[XB_TMO], 1u); break; } }
    }
    nloc = mine > 0u ? mine : 1u; nx = cnt > 0u ? cnt : 1u;
}
__device__ __attribute__((noinline)) void xcd_barrier_fn(unsigned* bar_, unsigned x_, unsigned stoff) {
    XcdBarrier b; b.bar = bar_; b.x = x_; b.st = (volatile LAS unsigned*)(unsigned long)stoff;
    asm volatile("s_waitcnt vmcnt(0)" ::: "memory");
    __syncthreads();
    if (threadIdx.x == 0) {
        unsigned* bar = b.bar;
        __builtin_amdgcn_s_waitcnt(0);
        unsigned nloc = b.st[0], nx = b.st[1];
        if (nloc == 0u) { xcd_barrier_complete(bar, b.x, nloc, nx); b.st[0] = nloc; b.st[1] = nx; }
        const unsigned old = xb_add(&bar[XB_XSUB(b.x)], 1u);
        const unsigned gen = old / nloc;
        if (old + 1u == (gen + 1u) * nloc) {
            __builtin_amdgcn_fence(__ATOMIC_RELEASE, "agent");
            asm volatile("s_waitcnt vmcnt(0)" ::: "memory");
            const unsigned og = xb_add(&bar[XB_TOP], 1u);
            const unsigned tg = og / nx;
            if (og + 1u == (tg + 1u) * nx) xb_add(&bar[XB_TOPGEN], 1u);
            else XB_SPIN(xb_ld(&bar[XB_TOPGEN]) == tg, bar);
            __builtin_amdgcn_fence(__ATOMIC_ACQUIRE, "agent");
            xb_add(&bar[XB_XGEN(b.x)], 1u);
            asm volatile("s_waitcnt vmcnt(0)" ::: "memory");
        } else {
            XB_SPIN(xb_ld(&bar[XB_XGEN(b.x)]) == gen, bar);
            __builtin_amdgcn_fence(__ATOMIC_ACQUIRE, "agent");
            asm volatile("s_waitcnt vmcnt(0)" ::: "memory");
        }
    }
    __syncthreads();
}


__device__ __forceinline__ const float* ldp(volatile LAS unsigned* q, int i) {
    const unsigned lo = __builtin_amdgcn_readfirstlane(q[2 * i]), hi = __builtin_amdgcn_readfirstlane(q[2 * i + 1]);
    return (const float*)(((unsigned long)hi << 32) | lo);
}
__device__ __forceinline__ Params load_params(LAS unsigned char* lds) {
    volatile LAS unsigned* q = (volatile LAS unsigned*)(lds + LDS_PARAM);
    Params P;
    P.x = ldp(q, 0); P.c = ldp(q, 1); P.ctx = ldp(q, 2); P.c_ctx = ldp(q, 3); P.w_mod = ldp(q, 4); P.b_mod = ldp(q, 5); P.norm_g = ldp(q, 6);
    P.w_in = ldp(q, 7); P.w_out = ldp(q, 8); P.lam_re = ldp(q, 9); P.lam_im = ldp(q, 10); P.log_dt = ldp(q, 11); P.b_re = ldp(q, 12); P.b_im = ldp(q, 13);
    P.c_re = ldp(q, 14); P.c_im = ldp(q, 15); P.s5_d = ldp(q, 16); P.w_glu = ldp(q, 17); P.rpb = ldp(q, 18); P.w_f = ldp(q, 19); P.w_ff1 = ldp(q, 20); P.w_ff2 = ldp(q, 21);
    P.out = (float*)ldp(q, 22); P.ws = (unsigned char*)ldp(q, 23);
    return P;
}
__global__ void __launch_bounds__(NTHR, 2) mega(Params Pk) {
    extern __shared__ __attribute__((aligned(16))) unsigned char shm[];
    LAS unsigned char* lds = (LAS unsigned char*)shm;
    cg::grid_group grid = cg::this_grid();
    if (threadIdx.x == 0) { volatile LAS unsigned long* q = (volatile LAS unsigned long*)(lds + LDS_PARAM);
        q[0] = (unsigned long)Pk.x; q[1] = (unsigned long)Pk.c; q[2] = (unsigned long)Pk.ctx; q[3] = (unsigned long)Pk.c_ctx; q[4] = (unsigned long)Pk.w_mod; q[5] = (unsigned long)Pk.b_mod;
        q[6] = (unsigned long)Pk.norm_g; q[7] = (unsigned long)Pk.w_in; q[8] = (unsigned long)Pk.w_out; q[9] = (unsigned long)Pk.lam_re; q[10] = (unsigned long)Pk.lam_im; q[11] = (unsigned long)Pk.log_dt;
        q[12] = (unsigned long)Pk.b_re; q[13] = (unsigned long)Pk.b_im; q[14] = (unsigned long)Pk.c_re; q[15] = (unsigned long)Pk.c_im; q[16] = (unsigned long)Pk.s5_d; q[17] = (unsigned long)Pk.w_glu;
        q[18] = (unsigned long)Pk.rpb; q[19] = (unsigned long)Pk.w_f; q[20] = (unsigned long)Pk.w_ff1; q[21] = (unsigned long)Pk.w_ff2; q[22] = (unsigned long)Pk.out; q[23] = (unsigned long)Pk.ws; }
    { volatile LAS unsigned* st0 = (volatile LAS unsigned*)(lds + LDS_STAGE); if (threadIdx.x < 16) st0[threadIdx.x] = 0u; }
    __syncthreads();
    if (blockIdx.x == 0) { unsigned* bw = (unsigned*)(Pk.ws + WS_BAR); for (int i = threadIdx.x; i < XCD_BAR_WORDS; i += NTHR) bw[i] = 0u; }
#define PHASE_BEGIN { const Params P = load_params(lds); int G = gridDim.x, bid = blockIdx.x; asm volatile("" : "+s"(G), "+s"(bid)); unsigned char* ws = P.ws; \
        bf16_t* ABUF = (bf16_t*)(ws + WS_ABUF); float* SCTX = (float*)(ws + WS_SCTX); const float* MOD = (const float*)(ws + WS_MOD); (void)ABUF; (void)SCTX; (void)MOD; (void)G; (void)bid;
#define PHASE_END   xcd_barrier_fn((unsigned*)(ws + WS_BAR), xb_xcc_id(), (unsigned)LDS_STAGE); }
#define PHASE_END_CG grid.sync(); }
#define PHASE_END_LAST }

    PHASE_BEGIN DUP(8, phase0(P, lds, G, bid)); PHASE_END_CG
    { const Params P = load_params(lds); (void)xcd_barrier_post((unsigned*)(P.ws + WS_BAR), (volatile LAS unsigned*)(lds + LDS_STAGE)); }
    PHASE_BEGIN
        RowArgs a{}; a.hin_lat = P.x; a.hin_ctx = P.ctx; a.hout_lat = (float*)P.x; a.hout_ctx = (float*)P.ctx; a.R = nullptr; a.A = ABUF; a.modB = MOD; a.shift_off = 0; a.scale_off = 1024; a.gainB = P.norm_g; a.nrows = TT;
        row_phase<0>(a, G, bid);
    PHASE_END

    for (int L = 0; L < 4; ++L) {
        const bool upd_ctx = L < 2;
        const int MT = upd_ctx ? TT / 256 : TL / 256;
#define HB_  ((bf16_t*)(ws + WS_W1))
#define W1T_ ((const bf16_t*)P.out)
#define W2T_ ((const bf16_t*)P.out + (size_t)4 * 4096 * 1024)
#define MODL (MOD + (size_t)L * 9 * 6144)
#define NGL  (P.norm_g + (size_t)L * 4 * 1024)
#define BIGP (ws + WS_BIG)
#define U_   ((bf16_t*)(BIGP + BG_U))
#define QKV_ ((bf16_t*)(BIGP + BG_QKV))
#define GB_  ((bf16_t*)(BIGP + BG_G))
#define RBE_ ((bf16_t*)(BIGP + BG_R))
#define ZA_  ((bf16_t*)(BIGP + BO_ZA))
#define YC_  ((bf16_t*)(BIGP + BO_YC))
#define PQC_ ((bf16_t*)(BIGP + BO_PQC))
#define AODD_ ((bf16_t*)(BIGP + BO_YC))
#define RBO_ ((bf16_t*)(BIGP + BO_R))
        if ((L & 1) == 0) {
            const int e = L >> 1;
            PHASE_BEGIN
                { const int skip = (1088 % G) < G / 2 ? (1088 % G) : 0;
                  if (bid >= skip) DUP(16, build_s5(P, e, G - skip, bid - skip)); }
                Gemm g{ABUF, (const bf16_t*)(ws + WS_WIN) + (size_t)e * 2048 * 1024, 0, 0, 1024, 1024, TT / 256, 8, 1, 1024};
                Epi<M_WIN> E{0, U_, QKV_, nullptr, 0.f}; DUP(1, gemm_phase(lds, g, E, G, bid));
            PHASE_END
            PHASE_BEGIN
                Gemm g{U_, (const bf16_t*)(BIGP + BG_WST), (long)UROWS * ULD, 256L * 1024, ULD, 1024, 3, 1, 32, 1024};
                Epi<M_SLOC> E{0, BIGP + BG_SLOC, nullptr, nullptr, 0.f}; DUP(1, gemm_phase(lds, g, E, G, (bid + 96) % G));
                DUP(4, na_phase(P, lds, e, upd_ctx, G, bid));
            PHASE_END
            PHASE_BEGIN DUP(16, carry_phase(P, e, G, bid)); PHASE_END
            PHASE_BEGIN
                Gemm g{U_, (const bf16_t*)(BIGP + BG_MG), (long)UROWS * ULD, 1024L * ULD, ULD, ULD, upd_ctx ? 3 : 2, 4, 32, ULD};
                Epi<M_YG> E{upd_ctx ? UROWS : 512, GB_, nullptr, nullptr, 0.f}; DUP(1, gemm_phase(lds, g, E, G, bid));
            PHASE_END
            PHASE_BEGIN
                Gemm g{GB_, (const bf16_t*)(ws + WS_WGLU) + (size_t)e * 512 * 512, 0, 0, 512, 512, MT, 2, 1, 512};
                Epi<M_GLU> E{0, ABUF, nullptr, GB_, 0.f}; DUP(1, gemm_phase(lds, g, E, G, bid));
            PHASE_END
            PHASE_BEGIN
                Gemm g{ABUF, (const bf16_t*)(ws + WS_WOUT) + (size_t)e * 1024 * 1024, 0, 0, 1024, 1024, TL / 256, 4, 1, 1024};
                Epi<M_PLAIN> E{1024, RBE_, nullptr, nullptr, 0.f}; DUP(1, gemm_phase(lds, g, E, G, bid));
                if (upd_ctx) { Gemm g2{ABUF + (size_t)TL * 1024, (const bf16_t*)(ws + WS_WOUT) + (size_t)e * 1024 * 1024, 256, 256, 1024, 1024, 8, 4, 4, 256};
                    Epi<M_PART> E2{0, ws + WS_PART, nullptr, nullptr, 0.f}; DUP(1, gemm_phase(lds, g2, E2, G, bid)); }
            PHASE_END
        } else {
            const int o = L >> 1;
            PHASE_BEGIN
                Gemm g{(const bf16_t*)(ws + WS_CDSD), AODD_, 0, 0, 1024, 1024, 4, MT, 1, 1024};
                Epi<M_PQ> E{0, ZA_, PQC_, nullptr, 0.f}; DUP(1, gemm_phase(lds, g, E, G, bid));
            PHASE_END
            PHASE_BEGIN
                Gemm g{(const bf16_t*)(ws + WS_DA), ZA_, 0, 0, 256, 256, 1, 1024, 1, 256};
                Epi<M_FA> E{0, YC_, nullptr, nullptr, 0.f}; DUP(2, gemm_phase(lds, g, E, G, bid));
                if (upd_ctx) { Gemm g2{(const bf16_t*)(ws + WS_AL256), PQC_, 0, 512, 512, 4096, 1, 4, 8, 512};
                    Epi<M_POSC> E2{0, ABUF, nullptr, nullptr, 1.f / 512.f}; DUP(2, gemm_phase(lds, g2, E2, G, bid)); }
            PHASE_END
            PHASE_BEGIN
                Gemm g{(const bf16_t*)(ws + WS_DC), YC_, 0, 0, 512, 512, 1, 512, 1, 512};
                Epi<M_FC> E{0, ABUF, nullptr, nullptr, 1.f / 2048.f}; DUP(2, gemm_phase(lds, g, E, G, bid));
            PHASE_END
            PHASE_BEGIN
                Gemm g{ABUF, (const bf16_t*)(ws + WS_WF) + (size_t)o * 1024 * 1024, 0, 0, 1024, 1024, TL / 256, 4, 1, 1024};
                Epi<M_PLAIN> E{1024, RBO_, nullptr, nullptr, 0.f}; DUP(1, gemm_phase(lds, g, E, G, bid));
                if (upd_ctx) { Gemm g2{ABUF + (size_t)TL * 1024, (const bf16_t*)(ws + WS_WF) + (size_t)o * 1024 * 1024, 256, 256, 1024, 1024, 8, 4, 4, 256};
                    Epi<M_PART> E2{0, ws + WS_PART, nullptr, nullptr, 0.f}; DUP(1, gemm_phase(lds, g2, E2, G, bid)); }
            PHASE_END
        }
        PHASE_BEGIN
            RowArgs a{}; a.hin_lat = P.x; a.hin_ctx = L == 0 ? P.ctx : SCTX; a.hout_lat = nullptr; a.hout_ctx = SCTX; a.hin_bf = HB_; a.hout_bf = HB_; a.R = (L & 1) ? RBO_ : RBE_; a.modA = MODL; a.gate_off = 2048; a.gainA = NGL + 1024;
            a.A = ABUF; a.modB = MODL; a.shift_off = 3072; a.scale_off = 4096; a.gainB = NGL + 2048; a.nrows = MT * 256; a.part = (const float*)(ws + WS_PART);
            if (L == 0) row_phase<1>(a, G, bid); else row_phase<2>(a, G, bid);
        PHASE_END
        PHASE_BEGIN
            Gemm g{ABUF, W1T_ + (size_t)L * 4096 * 1024, 0, 0, 1024, 1024, MT, 16, 1, 1024};
            Epi<M_SQRELU> E{4096, ws + WS_BIG, nullptr, nullptr, 0.f}; DUP(1, gemm_phase(lds, g, E, G, bid));
        PHASE_END
        PHASE_BEGIN
            Gemm g{(const bf16_t*)(ws + WS_BIG), W2T_ + (size_t)L * 1024 * 4096, 0, 0, 4096, 4096, TL / 256, 4, 1, 4096, 1};
            Epi<M_PLAIN> E{1024, ABUF, nullptr, nullptr, 0.f}; DUP(1, gemm_phase(lds, g, E, G, bid));
            if (upd_ctx) { Gemm g2{(const bf16_t*)(ws + WS_BIG) + (size_t)TL * 4096, W2T_ + (size_t)L * 1024 * 4096, 1024, 1024, 4096, 4096, 8, 4, 4, 1024};
                Epi<M_PART> E2{0, ws + WS_PART, nullptr, nullptr, 0.f}; DUP(1, gemm_phase(lds, g2, E2, G, bid)); }
        PHASE_END
        PHASE_BEGIN
            RowArgs a{}; a.hin_lat = nullptr; a.hin_ctx = SCTX; a.hout_lat = P.out; a.hout_ctx = SCTX; a.hin_bf = HB_; a.hout_bf = HB_; a.R = ABUF; a.modA = MODL; a.gate_off = 5120; a.gainA = NGL + 3072; a.nrows = MT * 256; a.part = (const float*)(ws + WS_PART);
            if (L < 3) { a.A = ((L + 1) & 1) ? AODD_ : ABUF; a.modB = MOD + (size_t)(L + 1) * 9 * 6144; a.shift_off = 0; a.scale_off = 1024; a.gainB = P.norm_g + (size_t)(L + 1) * 4 * 1024; a.perm = ((L + 1) & 1); } else a.A = nullptr;
            if (L < 3) row_phase<2>(a, G, bid); else row_phase<3>(a, G, bid);
            if (L < 3) xcd_barrier_fn((unsigned*)(ws + WS_BAR), xb_xcc_id(), (unsigned)LDS_STAGE);
        PHASE_END_LAST
    }
}
constexpr int N_PHASES = 2 + 10 + 8 + 10 + 8;

extern "C" void kernel_launch(void* const* d_in, const int* in_sizes, int n_in, void* d_out, int out_size, void* d_ws, size_t ws_size, hipStream_t stream) {
    static int grid = 0;
    if (grid == 0) {
        if (n_in != 22 || ws_size < WS_END) { fprintf(stderr, "kernel_launch: unexpected n_in %d / ws_size %zu (need %zu)\n", n_in, ws_size, (size_t)WS_END); grid = -1; return; }
        int dev = 0, cus = 0, per_cu = 0;
        hipGetDevice(&dev); hipDeviceGetAttribute(&cus, hipDeviceAttributeMultiprocessorCount, dev);
        if (hipFuncSetAttribute((const void*)mega, hipFuncAttributeMaxDynamicSharedMemorySize, LDS_BYTES) != hipSuccess) { fprintf(stderr, "hipFuncSetAttribute failed\n"); grid = -1; return; }
        if (hipOccupancyMaxActiveBlocksPerMultiprocessor(&per_cu, (const void*)mega, NTHR, LDS_BYTES) != hipSuccess || per_cu < 1) { fprintf(stderr, "occupancy query: %d\n", per_cu); per_cu = 1; }
        (void)hipGetLastError();
        grid = cus * 1;
    }
    if (grid < 0) return;
    Params p{};
    const float** pp = (const float**)&p;
    for (int i = 0; i < 22; ++i) pp[i] = (const float*)d_in[i];
    p.out = (float*)d_out; p.ws = (unsigned char*)d_ws;
#if N_LAUNCH_MODE == 1
    void* args[] = {&p};
    hipError_t e = hipLaunchCooperativeKernel((const void*)mega, dim3(grid), dim3(NTHR), args, LDS_BYTES, stream);
    if (e != hipSuccess) fprintf(stderr, "cooperative launch failed: %s (grid %d)\n", hipGetErrorString(e), grid);
#else
    fprintf(stderr, "per-phase launch mode removed\n");
#endif
}
```

```cpp
#include <hip/hip_runtime.h>
#include <hip/hip_cooperative_groups.h>
#include <cstdio>
namespace cg = cooperative_groups;

#ifndef N_LAUNCH_MODE
#define N_LAUNCH_MODE 1
#endif

#ifndef DUPMASK
#define DUPMASK 0
#endif
#define DUP(bit, stmt) do { _Pragma("nounroll") for (int _rep = 0; _rep < ((DUPMASK & (bit)) ? 2 : 1); ++_rep) { stmt; } } while (0)
#define LAS __attribute__((address_space(3)))
typedef unsigned short bf16_t;
typedef short bf16x8 __attribute__((ext_vector_type(8)));
typedef float f32x4 __attribute__((ext_vector_type(4)));
typedef float f32x2 __attribute__((ext_vector_type(2)));
typedef unsigned u32x4 __attribute__((ext_vector_type(4)));
typedef unsigned u32x2 __attribute__((ext_vector_type(2)));

constexpr int D = 1024, TL = 32768, TC = 2048, TT = 34816, DFF = 4096;
constexpr int NTHR = 512;
constexpr int LDS_STAGE = 131072;
constexpr int LDS_PARAM = LDS_STAGE + 64;
constexpr int LDS_BYTES = LDS_PARAM + 256;
constexpr size_t MiB = 1048576;
constexpr size_t WS_SCTX = 0, WS_MOD = 8 * MiB, WS_WIN = 9 * MiB, WS_WOUT = 17 * MiB, WS_WGLU = 21 * MiB, WS_WF = 22 * MiB,
                 WS_W1 = 26 * MiB, WS_W2 = 58 * MiB, WS_CDSD = 90 * MiB, WS_AL = 94 * MiB, WS_AL256 = 126 * MiB, WS_KTAB = 127 * MiB,
                 WS_BBAR = 135 * MiB, WS_ABUF = 136 * MiB, WS_BIG = 204 * MiB, WS_BAR = 476 * MiB, WS_PART = 477 * MiB, WS_END = 509 * MiB;
constexpr size_t BG_MG = 0, BG_WST = 80 * MiB, BG_U = 96 * MiB, BG_SLOC = 139 * MiB, BG_QKV = 156 * MiB, BG_G = BG_QKV, BG_R = BG_QKV + 34 * MiB;
constexpr size_t BO_ZA = 0, BO_YC = 128 * MiB, BO_PQC = 256 * MiB, BO_R = 0;
constexpr size_t WS_DA = WS_AL, WS_DC = WS_AL + 1 * MiB, WS_APOW = WS_AL + 2 * MiB;
constexpr int PQ_LD = 69632;
constexpr int UROWS = 544, ULD = 1280;

struct Params {
    const float* x; const float* c; const float* ctx; const float* c_ctx; const float* w_mod; const float* b_mod; const float* norm_g;
    const float* w_in; const float* w_out; const float* lam_re; const float* lam_im; const float* log_dt; const float* b_re; const float* b_im;
    const float* c_re; const float* c_im; const float* s5_d; const float* w_glu; const float* rpb; const float* w_f; const float* w_ff1; const float* w_ff2;
    float* out; unsigned char* ws;
};

__device__ __forceinline__ unsigned cvt_pk_bf16(float lo, float hi) { unsigned r; asm volatile("v_cvt_pk_bf16_f32 %0, %1, %2" : "=v"(r) : "v"(lo), "v"(hi)); return r; }
__device__ __forceinline__ bf16_t f2bf(float f) { return (bf16_t)(cvt_pk_bf16(f, 0.f) & 0xffffu); }
__device__ __forceinline__ float bf2f(unsigned short b) { return __uint_as_float(((unsigned)b) << 16); }
__device__ __forceinline__ float bflo(unsigned w) { return __uint_as_float(w << 16); }
__device__ __forceinline__ float bfhi(unsigned w) { return __uint_as_float(w & 0xffff0000u); }
__device__ __forceinline__ u32x4 pack8(f32x4 a, f32x4 b) { u32x4 r; r[0] = cvt_pk_bf16(a[0], a[1]); r[1] = cvt_pk_bf16(a[2], a[3]); r[2] = cvt_pk_bf16(b[0], b[1]); r[3] = cvt_pk_bf16(b[2], b[3]); return r; }
__device__ __forceinline__ int tid_opaque() { int t = threadIdx.x; asm volatile("" : "+v"(t)); return t; }
__device__ __forceinline__ float wave_sum(float v) { for (int o = 32; o > 0; o >>= 1) v += __shfl_xor(v, o); return v; }
__device__ __forceinline__ float gelu_tanh(float y) { const float z = 0.7978845608028654f * (y + 0.044715f * y * y * y); const float t = 1.f - 2.f / (__expf(2.f * z) + 1.f); return 0.5f * y * (1.f + t); }
__device__ __forceinline__ float sigmoidf(float v) { return 1.f / (1.f + __expf(-v)); }

__device__ __forceinline__ void apow(const Params& P, int e, int dir, int g, int p, float pw, float& ar, float& ai) {
    const int gi = (e * 2 + dir) * 32 + g, idx = gi * 64 + p;
    const float lr = fminf(P.lam_re[idx], -1e-4f), li = P.lam_im[idx], dt = expf(P.log_dt[gi]);
    const float mag = expf(lr * dt * pw);
    double rev = (double)li * (double)dt * (double)pw * 0.15915494309189535; rev -= floor(rev);
    const float ang = (float)rev * 6.283185307179586f;
    ar = mag * cosf(ang); ai = mag * sinf(ang);
}

constexpr int BM = 256, BK = 64, HALF = 128, HTB = HALF * BK * 2, NXCD = 8, WGM = 8;
__device__ __forceinline__ int lds_byte(int r, int c) { const int st = (r >> 4) * 2 + (c >> 5), rr = r & 15, cc = c & 31, ob = rr * 64 + cc * 2; return st * 1024 + (ob ^ (((ob >> 9) & 1) << 5)); }
__device__ __forceinline__ void stage_rc(int b, int& R, int& C) { const int st = b / 1024, sb = b % 1024, swz = sb ^ (((sb >> 9) & 1) << 5); R = (st >> 1) * 16 + swz / 64; C = (st & 1) * 32 + (swz % 64) / 2; }
__device__ __forceinline__ int perm32(int rho) { const int n = rho >> 4, i = rho & 15; return 8 * (i >> 2) + 4 * n + (i & 3); }

struct Unit { int pm, pn, pb; };
struct Gemm { const bf16_t* A; const bf16_t* Bt; long sA, sB; int lda, ldb, nM, nN, nB, K; int rev = 0; };
struct Order {
    int nM, nN, nwg, total, G, c, rev;
    __device__ void init(const Gemm& g, int G_, int c_) { nM = g.nM; nN = g.nN; nwg = nM * nN; total = nwg * g.nB; G = G_; c = c_; rev = g.rev; }
    __device__ bool next(int i, Unit& u) const {
        const long L = (long)i * G + c; if (L >= total) return false;
        const int pb = (int)(L / nwg); int wgid = (int)(L - (long)pb * nwg);
        { const int q = nwg / NXCD, r = nwg % NXCD, xcd = wgid % NXCD, off = wgid / NXCD; wgid = (xcd < r ? xcd * (q + 1) : r * (q + 1) + (xcd - r) * q) + off; }
        const int nig = WGM * nN, gid = wgid / nig, fm = gid * WGM, gsz = (nM - fm) < WGM ? (nM - fm) : WGM;
        u.pm = fm + ((wgid % nig) % gsz); u.pn = (wgid % nig) / gsz; u.pb = pb; if (rev) u.pm = nM - 1 - u.pm; return true;
    }
};

enum { M_PLAIN = 0, M_SQRELU, M_WIN, M_SLOC, M_YG, M_GLU, M_PQ, M_POS, M_POSC, M_PART, M_FA, M_FC };
template <int MODE> struct Epi {
    static constexpr int mode = MODE; int p0; void* o0; void* o1; const void* i0; float f0;
    __device__ __forceinline__ void store8(int pb, int row, int col0, f32x4 v0, f32x4 v1) const {
        switch (mode) {
        case M_PLAIN: { *(u32x4*)((bf16_t*)o0 + (size_t)row * p0 + col0) = pack8(v0, v1); } break;
        case M_SQRELU: {
#pragma unroll
            for (int i = 0; i < 4; ++i) { float a, b; asm("v_max_f32 %0, 0, %1" : "=v"(a) : "v"(v0[i])); asm("v_max_f32 %0, 0, %1" : "=v"(b) : "v"(v1[i])); v0[i] = a; v1[i] = b; }
            v0 *= v0; v1 *= v1;
            *(u32x4*)((bf16_t*)o0 + (size_t)row * p0 + col0) = pack8(v0, v1); } break;
        case M_WIN: {
            if (col0 < 512) { const int g = col0 >> 4, h0 = col0 & 15, r = row >> 6, j = row & 63;
                *(u32x4*)((bf16_t*)o0 + ((size_t)(g * UROWS + r) * ULD + j * 16 + h0)) = pack8(v0, v1); }
            else if (col0 < 1536) { if (col0 < 1024) { v0 *= 0.125f * 1.4426950408889634f; v1 *= 0.125f * 1.4426950408889634f; }
                *(u32x4*)((bf16_t*)o1 + (size_t)row * 1024 + (col0 - 512)) = pack8(v0, v1); }
            else { const u32x4 pk = pack8(v0, v1); bf16_t* vt = (bf16_t*)o1 + (size_t)TT * 1024 + (size_t)(col0 - 1536) * TT + row;
#pragma unroll
                for (int e = 0; e < 8; ++e) { const unsigned w = pk[e >> 1]; vt[(size_t)e * TT] = (bf16_t)((e & 1) ? (w >> 16) : (w & 0xffffu)); } } } break;
        case M_SLOC: { if (row < UROWS) { float* dst = (float*)o0 + ((size_t)(pb * UROWS + row) * 256 + col0); *(f32x4*)dst = v0; *(f32x4*)(dst + 4) = v1; } } break;
        case M_YG: { if (row < p0) { const int token = row < 512 ? row * 64 : TL + (row - 512) * 64; const int i = col0 >> 4, ho0 = col0 & 15;
#pragma unroll
                for (int k = 0; k < 4; ++k) { v0[k] = gelu_tanh(v0[k]); v1[k] = gelu_tanh(v1[k]); }
                *(u32x4*)((bf16_t*)o0 + (size_t)(token + i) * 512 + pb * 16 + ho0) = pack8(v0, v1); } } break;
        case M_GLU: { const u32x4 gv = *(const u32x4*)((const bf16_t*)i0 + (size_t)row * 512 + col0);
            v0[0] = bflo(gv[0]) * sigmoidf(v0[0]); v0[1] = bfhi(gv[0]) * sigmoidf(v0[1]); v0[2] = bflo(gv[1]) * sigmoidf(v0[2]); v0[3] = bfhi(gv[1]) * sigmoidf(v0[3]);
            v1[0] = bflo(gv[2]) * sigmoidf(v1[0]); v1[1] = bfhi(gv[2]) * sigmoidf(v1[1]); v1[2] = bflo(gv[3]) * sigmoidf(v1[2]); v1[3] = bfhi(gv[3]) * sigmoidf(v1[3]);
            *(u32x4*)((bf16_t*)o0 + (size_t)row * 1024 + col0) = pack8(v0, v1); } break;
        case M_PQ: {
            const bool isSin = row >= 513; const int m = isSin ? row - 512 : row; const int co = isSin ? 64 : 0;
            const u32x4 pk = pack8(v0, v1); const u32x4 npk = pack8(-v0, -v1); const u32x4 zz = {0u, 0u, 0u, 0u};
            if (col0 < TL) { bf16_t* ZA = (bf16_t*)o0; const int b = col0 >> 12, pi = col0 & 4095, t2 = pi >> 6, t1 = pi & 63, tp = t2 >> 1, j = t2 & 1;
                const size_t inner = (size_t)tp * 256 + j * 128 + co + t1;
                *(u32x4*)(ZA + (size_t)(b * 1024 + m) * 8192 + inner) = pk;
                if (m >= 1 && m <= 511) *(u32x4*)(ZA + (size_t)(b * 1024 + 1024 - m) * 8192 + inner) = isSin ? npk : pk;
                if (!isSin && (m == 0 || m == 512)) *(u32x4*)(ZA + (size_t)(b * 1024 + m) * 8192 + inner + 64) = zz; }
            else { bf16_t* PC = (bf16_t*)o1; const int tt = col0 - TL, b = tt >> 8, t = tt & 255; const size_t inner = (size_t)b * 512 + (isSin ? 256 : 0) + t;
                *(u32x4*)(PC + (size_t)m * 4096 + inner) = pk;
                if (m >= 1 && m <= 511) *(u32x4*)(PC + (size_t)(1024 - m) * 4096 + inner) = isSin ? npk : pk;
                if (!isSin && (m == 0 || m == 512)) *(u32x4*)(PC + (size_t)m * 4096 + inner + 256) = zz; } } break;
        case M_FC: { v0 *= f0; v1 *= f0; const int jj = row >> 6, k2 = row & 63, m0 = col0 & 1023, kq = (col0 >> 10) & 15, b = col0 >> 14; const int k = 4 * kq + jj + 64 * k2;
            *(u32x4*)((bf16_t*)o0 + ((size_t)(b * 4096 + k)) * 1024 + m0) = pack8(v0, v1); } break;
        case M_POSC: { v0 *= f0; v1 *= f0; *(u32x4*)((bf16_t*)o0 + ((size_t)(TL + pb * 256 + row)) * 1024 + col0) = pack8(v0, v1); } break;
        case M_PART: { float* dst = (float*)o0 + ((size_t)(pb * 2048 + row) * 1024 + col0); *(f32x4*)dst = v0; *(f32x4*)(dst + 4) = v1; } break;
        }
    }
    __device__ __forceinline__ void operator()(const f32x4 (&acc)[2][2][4][2], const Unit& u, int wr, int wc, int fr, int fq) const {
        asm volatile("" : "+v"(fr), "+v"(fq));
        if constexpr (MODE == M_FA) {
            bf16_t* YC = (bf16_t*)o0; const int j = wr;
#pragma unroll
            for (int m = 0; m < 4; ++m) { const int k1 = 16 * m + fr, kq = k1 >> 2, jj = k1 & 3;
#pragma unroll
                for (int bj = 0; bj < 2; ++bj) { const int col0 = u.pn * BM + bj * HALF + wc * 32 + 8 * fq; const int tp0 = col0 & 31, mch = (col0 >> 5) & 1023, b = col0 >> 15;
                    f32x4 r0, r1, i0, i1;
#pragma unroll
                    for (int e = 0; e < 8; ++e) { const float yr = e < 4 ? acc[0][bj][m][0][e & 3] : acc[0][bj][m][1][e & 3], yi = e < 4 ? acc[1][bj][m][0][e & 3] : acc[1][bj][m][1][e & 3];
                        const float ph = (float)(k1 * (2 * (tp0 + e) + j)) * (6.283185307179586f / 4096.f); const float cs = __cosf(ph), sn = __sinf(ph);
                        const float orr = yr * cs + yi * sn, oi = yi * cs - yr * sn;
                        if (e < 4) { r0[e & 3] = orr; i0[e & 3] = oi; } else { r1[e & 3] = orr; i1[e & 3] = oi; } }
                    bf16_t* dst = YC + ((size_t)((b * 16 + kq) * 1024 + mch)) * 512 + jj * 128 + j * 32 + tp0;
                    *(u32x4*)dst = pack8(r0, r1); *(u32x4*)(dst + 64) = pack8(i0, i1); __builtin_amdgcn_sched_barrier(0); } }
        } else {
#pragma unroll
        for (int ai = 0; ai < 2; ++ai)
#pragma unroll
            for (int m = 0; m < 4; ++m) { const int row = u.pm * BM + ai * HALF + wr * 64 + m * 16 + fr;
#pragma unroll
                for (int bj = 0; bj < 2; ++bj) { const int col0 = u.pn * BM + bj * HALF + wc * 32 + 8 * fq; store8(u.pb, row, col0, acc[ai][bj][m][0], acc[ai][bj][m][1]); } }
        }
    }
};

template <int MODE> __device__ __forceinline__ void gemm_phase(LAS unsigned char* lds, const Gemm g, const Epi<MODE>& E, int G, int bid) {
    Order S; S.init(g, G, bid);
    const int tid = tid_opaque(), wid = __builtin_amdgcn_readfirstlane(tid >> 6), lane = tid & 63, wr = wid >> 2, wc = wid & 3, fr = lane & 15, fq = lane >> 4;
    int K = g.K; asm volatile("" : "+s"(K));
    const int nt = K / BK;
    unsigned voffA[2], voffB[2];
#pragma unroll
    for (int i = 0; i < 2; ++i) { int R, C; stage_rc(tid * 16 + i * 8192, R, C); const int Rb = (R & ~31) + perm32(R & 31);
        voffA[i] = (unsigned)(R * g.lda + C) * 2u; voffB[i] = (unsigned)(Rb * g.ldb + C) * 2u; }
    const size_t kstep = (size_t)(BK * 2);
    const size_t hstepA = (size_t)HALF * g.lda * 2, hstepB = (size_t)HALF * g.ldb * 2;
    const size_t tstepA = 2 * hstepA, tstepB = 2 * hstepB;
    const unsigned ldsw = (unsigned)wid * 1024u;
    const int aoff = lds_byte(wr * 64 + fr, fq * 8), boff = lds_byte(wc * 32 + fr, fq * 8);
#define PG8_SA(b, h) (((b) * 2 + (h)) * HTB)
#define PG8_SB(b, h) ((4 + (b) * 2 + (h)) * HTB)
#define PG8_STAGE(bufoff, gbase, voff) do { _Pragma("unroll") for (int _i = 0; _i < 2; ++_i) \
        __builtin_amdgcn_global_load_lds((const unsigned*)((const char*)(gbase) + (voff)[_i]), (LAS unsigned*)(lds + (bufoff) + ldsw + _i * 8192), 16, 0, 0); } while (0)
#define PG8_LDA(dst, b, h) do { _Pragma("unroll") for (int m = 0; m < 4; ++m) _Pragma("unroll") for (int k = 0; k < 2; ++k) dst[m][k] = *(const LAS bf16x8*)(lds + PG8_SA(b, h) + aoff + m * 2048 + k * 1024); } while (0)
#define PG8_LDB(dst, b, h) do { _Pragma("unroll") for (int n = 0; n < 2; ++n) _Pragma("unroll") for (int k = 0; k < 2; ++k) dst[n][k] = *(const LAS bf16x8*)(lds + PG8_SB(b, h) + boff + n * 2048 + k * 1024); } while (0)
#define PG8_MMA(ai, bj, At, Bt) do { __builtin_amdgcn_s_setprio(1); _Pragma("unroll") for (int m = 0; m < 4; ++m) _Pragma("unroll") for (int n = 0; n < 2; ++n) _Pragma("unroll") for (int k = 0; k < 2; ++k) \
        acc[ai][bj][m][n] = __builtin_amdgcn_mfma_f32_16x16x32_bf16(Bt[n][k], At[m][k], acc[ai][bj][m][n], 0, 0, 0); __builtin_amdgcn_s_setprio(0); } while (0)
#define PG8_WAIT_V(n) asm volatile("s_waitcnt vmcnt(" #n ")" ::: "memory")
#define PG8_WAIT_L(n) asm volatile("s_waitcnt lgkmcnt(" #n ")" ::: "memory")
#define PG8_BAR __builtin_amdgcn_s_barrier()
#define PG8_SCHED __builtin_amdgcn_sched_barrier(0)
    Unit cur, nxt; int ui = 0;
    if (!S.next(0, cur)) return;
    f32x4 acc[2][2][4][2];
#pragma unroll
    for (int a = 0; a < 2; ++a)
#pragma unroll
        for (int b = 0; b < 2; ++b)
#pragma unroll
            for (int m = 0; m < 4; ++m)
#pragma unroll
                for (int n = 0; n < 2; ++n) acc[a][b][m][n] = (f32x4){0.f, 0.f, 0.f, 0.f};
    bf16x8 At[4][2], B0[2][2], B1[2][2];
    const char* cA = (const char*)g.A + (size_t)cur.pb * g.sA * 2 + (size_t)cur.pm * tstepA;
    const char* cB = (const char*)g.Bt + (size_t)cur.pb * g.sB * 2 + (size_t)cur.pn * tstepB;
    PG8_STAGE(PG8_SB(0, 0), cB, voffB); PG8_STAGE(PG8_SB(0, 1), cB + hstepB, voffB); PG8_STAGE(PG8_SA(0, 0), cA, voffA); PG8_STAGE(PG8_SA(0, 1), cA + hstepA, voffA);
    if (wr == 1) PG8_BAR;
    PG8_WAIT_V(2); PG8_BAR;
    PG8_STAGE(PG8_SB(1, 0), cB + kstep, voffB); PG8_STAGE(PG8_SA(1, 0), cA + kstep, voffA); PG8_STAGE(PG8_SB(1, 1), cB + hstepB + kstep, voffB);
    PG8_WAIT_V(6); PG8_BAR;
    for (;;) {
        const bool has_next = S.next(ui + 1, nxt);
        const char* nA = has_next ? (const char*)g.A + (size_t)nxt.pb * g.sA * 2 + (size_t)nxt.pm * tstepA : cA;
        const char* nB = has_next ? (const char*)g.Bt + (size_t)nxt.pb * g.sB * 2 + (size_t)nxt.pn * tstepB : cB;
        for (int t = 0; t < nt; t += 2) {
            const bool last = (t == nt - 2);
            const char* a1 = cA + (size_t)(t + 1) * kstep;
            const char* a2 = last ? nA : cA + (size_t)(t + 2) * kstep; const char* b2 = last ? nB : cB + (size_t)(t + 2) * kstep;
            const char* a3 = a2 + kstep; const char* b3 = b2 + kstep;
            PG8_LDB(B0, 0, 0); PG8_LDB(B1, 0, 1); PG8_SCHED; PG8_LDA(At, 0, 0); PG8_STAGE(PG8_SA(1, 1), a1 + hstepA, voffA);
            PG8_WAIT_V(8); PG8_WAIT_L(0); PG8_BAR; PG8_MMA(0, 0, At, B0); PG8_MMA(0, 1, At, B1); PG8_BAR; PG8_SCHED;
            PG8_LDA(At, 0, 1); PG8_STAGE(PG8_SB(0, 0), b2, voffB); PG8_STAGE(PG8_SB(0, 1), b2 + hstepB, voffB); PG8_STAGE(PG8_SA(0, 0), a2, voffA);
            PG8_WAIT_V(8); PG8_WAIT_L(0); PG8_BAR; PG8_MMA(1, 0, At, B0); PG8_MMA(1, 1, At, B1); PG8_BAR; PG8_SCHED;
            PG8_LDB(B0, 1, 0); PG8_LDB(B1, 1, 1); PG8_SCHED; PG8_LDA(At, 1, 0); PG8_STAGE(PG8_SA(0, 1), a2 + hstepA, voffA);
            PG8_WAIT_V(8); PG8_WAIT_L(0); PG8_BAR; PG8_MMA(0, 0, At, B0); PG8_MMA(0, 1, At, B1); PG8_BAR; PG8_SCHED;
            PG8_LDA(At, 1, 1); PG8_STAGE(PG8_SB(1, 0), b3, voffB); PG8_STAGE(PG8_SB(1, 1), b3 + hstepB, voffB); PG8_STAGE(PG8_SA(1, 0), a3, voffA);
            PG8_WAIT_V(8); PG8_WAIT_L(0); PG8_BAR; PG8_MMA(1, 0, At, B0); PG8_MMA(1, 1, At, B1); PG8_BAR; PG8_SCHED;
        }
        if (wr == 0) PG8_BAR;
        E(acc, cur, wr, wc, fr, fq);
        if (!has_next) break;
#pragma unroll
        for (int a = 0; a < 2; ++a)
#pragma unroll
            for (int b = 0; b < 2; ++b)
#pragma unroll
                for (int m = 0; m < 4; ++m)
#pragma unroll
                    for (int n = 0; n < 2; ++n) acc[a][b][m][n] = (f32x4){0.f, 0.f, 0.f, 0.f};
        cur = nxt; cA = nA; cB = nB; ++ui;
        if (wr == 1) PG8_BAR;
    }
    PG8_WAIT_V(0);
    PG8_BAR;
#undef PG8_SA
#undef PG8_SB
#undef PG8_STAGE
#undef PG8_LDA
#undef PG8_LDB
#undef PG8_MMA
#undef PG8_WAIT_V
#undef PG8_WAIT_L
#undef PG8_BAR
#undef PG8_SCHED
}

struct TJob { const float* W; bf16_t* WT; int K, N, t; };
__device__ __forceinline__ void tjob_load(const TJob& j, int tid, f32x4 (&va)[4], f32x4 (&vb)[4]) {
    const int ntn = j.N / 64, kp = tid >> 4, n0 = (tid & 15) * 4;
#pragma unroll
    for (int q = 0; q < 4; ++q) { const int tile = j.t + q, tk = tile / ntn, tn = tile % ntn; const float* src = j.W + (size_t)(tk * 64 + 2 * kp) * j.N + tn * 64 + n0; va[q] = __builtin_nontemporal_load((const f32x4*)src); vb[q] = __builtin_nontemporal_load((const f32x4*)(src + j.N)); }
}
__device__ __forceinline__ void tjob_store(LAS unsigned char* lds, const TJob& j, int tid, const f32x4 (&va)[4], const f32x4 (&vb)[4]) {
    const int ntn = j.N / 64; LAS unsigned* t32 = (LAS unsigned*)lds;
    { const int kp = tid >> 4, n0 = (tid & 15) * 4;
#pragma unroll
      for (int q = 0; q < 4; ++q)
#pragma unroll
          for (int i = 0; i < 4; ++i) t32[q * 64 * 33 + (n0 + i) * 33 + kp] = cvt_pk_bf16(va[q][i], vb[q][i]); }
    __syncthreads();
    { const int n = tid >> 3, k0 = (tid & 7) * 8;
#pragma unroll
      for (int q = 0; q < 4; ++q) { const int tile = j.t + q, tk = tile / ntn, tn = tile % ntn; const LAS unsigned* r = t32 + q * 64 * 33 + n * 33 + (k0 >> 1);
          u32x4 v; v[0] = r[0]; v[1] = r[1]; v[2] = r[2]; v[3] = r[3];
          *(u32x4*)(j.WT + (size_t)(tn * 64 + n) * j.K + tk * 64 + k0) = v; } }
    __syncthreads();
}

constexpr int MOD_SC_OFF = 65536, MOD_RED_OFF = MOD_SC_OFF + 9 * 1024 * 4;
__device__ __forceinline__ void mod_stage(const Params& P, LAS unsigned char* lds) {
    const int tid = tid_opaque(); LAS float* sc = (LAS float*)(lds + MOD_SC_OFF);
    float v[18];
#pragma unroll
    for (int j = 0; j < 18; ++j) { const int i = tid + NTHR * j, bi = i >> 10, k = i & 1023; v[j] = bi < 8 ? P.c[bi * 1024 + k] : P.c_ctx[k]; }
#pragma unroll
    for (int j = 0; j < 18; ++j) sc[tid + NTHR * j] = v[j] * __builtin_amdgcn_rcpf(1.f + __expf(-v[j]));
    __syncthreads();
}
__device__ __forceinline__ void mod_unit(const Params& P, LAS unsigned char* lds, float* MOD, int u) {
    const int tid = tid_opaque(); const int L = u / 192, n0 = (u % 192) * 32;
    LAS float* sc = (LAS float*)(lds + MOD_SC_OFF);
    LAS float* red = (LAS float*)(lds + MOD_RED_OFF);
    const int col = tid & 31, kp = tid >> 5;
    float acc[9];
#pragma unroll
    for (int b = 0; b < 9; ++b) acc[b] = 0.f;
    const float* w = P.w_mod + (size_t)L * 1024 * 6144 + (size_t)(kp * 64) * 6144 + n0 + col;
#pragma unroll
    for (int h = 0; h < 2; ++h) { float wv[32];
#pragma unroll
        for (int j = 0; j < 32; ++j) wv[j] = __builtin_nontemporal_load(w + (size_t)(h * 32 + j) * 6144);
#pragma unroll
        for (int j = 0; j < 32; ++j) { const int k = kp * 64 + h * 32 + j;
#pragma unroll
            for (int b = 0; b < 9; ++b) acc[b] += sc[b * 1024 + k] * wv[j]; } }
#pragma unroll
    for (int b = 0; b < 9; ++b) red[(kp * 9 + b) * 32 + col] = acc[b];
    __syncthreads();
    if (tid < 288) { const int b = tid >> 5, cc = tid & 31; float sm = P.b_mod[L * 6144 + n0 + cc];
#pragma unroll
        for (int q = 0; q < 16; ++q) sm += red[(q * 9 + b) * 32 + cc];
        MOD[(size_t)(L * 9 + b) * 6144 + n0 + cc] = sm; }
    __syncthreads();
}

__device__ __forceinline__ void ktab_unit(const Params& P, LAS unsigned char* lds, float* KTAB, float* BBAR, float* APOW, int u) {
    const int tid = tid_opaque(); const int half = u & 1, gi = u >> 1, g = gi & 31, dir = (gi >> 5) & 1, e = gi >> 6;
    LAS float* ap = (LAS float*)lds;
    LAS float* Cm = ap + 33 * 128;
    LAS float* Bb = Cm + 2048;
    const int nl = half ? 33 : 32;
    for (int i = tid; i < nl * 64; i += NTHR) { const int ll = i >> 6, p = i & 63, l = 32 * half + ll; float ar, ai; apow(P, e, dir, g, p, (float)l, ar, ai); ap[2 * i] = ar; ap[2 * i + 1] = ai;
        APOW[((size_t)(gi * 65 + l) * 64 + p) * 2] = ar; APOW[((size_t)(gi * 65 + l) * 64 + p) * 2 + 1] = ai; }
    for (int i = tid; i < 1024; i += NTHR) { const int ho = i >> 6, p = i & 63; Cm[2 * i] = P.c_re[(size_t)(gi * 16 + ho) * 64 + p]; Cm[2 * i + 1] = P.c_im[(size_t)(gi * 16 + ho) * 64 + p]; }
    for (int i = tid; i < 1024; i += NTHR) { const int p = i >> 4, hi = i & 15; float ar, ai; apow(P, e, dir, g, p, 1.f, ar, ai);
        const float lr = fminf(P.lam_re[gi * 64 + p], -1e-4f), li = P.lam_im[gi * 64 + p], den = lr * lr + li * li, nr = ar - 1.f;
        const float fre = (nr * lr + ai * li) / den, fim = (ai * lr - nr * li) / den;
        const float br = P.b_re[(size_t)(gi * 64 + p) * 16 + hi], bi = P.b_im[(size_t)(gi * 64 + p) * 16 + hi];
        const float bbr = fre * br - fim * bi, bbi = fre * bi + fim * br;
        Bb[2 * i] = bbr; Bb[2 * i + 1] = bbi; if (half == 0) { BBAR[((size_t)gi * 1024 + i) * 2] = bbr; BBAR[((size_t)gi * 1024 + i) * 2 + 1] = bbi; } }
    __syncthreads();
    { const int ll = tid >> 4, ho = tid & 15, l = 32 * half + ll; float acc[16];
#pragma unroll
      for (int hi = 0; hi < 16; ++hi) acc[hi] = 0.f;
      for (int p = 0; p < 64; ++p) { const f32x2 cc = *(const LAS f32x2*)(Cm + (ho * 64 + p) * 2), aa = *(const LAS f32x2*)(ap + (ll * 64 + p) * 2);
          const float wr = cc[0] * aa[0] - cc[1] * aa[1], wi = cc[0] * aa[1] + cc[1] * aa[0];
#pragma unroll
          for (int h4 = 0; h4 < 8; ++h4) { const f32x4 bb = *(const LAS f32x4*)(Bb + p * 32 + h4 * 4); acc[2 * h4] += wr * bb[0] - wi * bb[1]; acc[2 * h4 + 1] += wr * bb[2] - wi * bb[3]; } }
      float* dst = KTAB + ((size_t)(gi * 64 + l)) * 256 + ho * 16;
#pragma unroll
      for (int h4 = 0; h4 < 4; ++h4) *(f32x4*)(dst + 4 * h4) = (f32x4){acc[4 * h4], acc[4 * h4 + 1], acc[4 * h4 + 2], acc[4 * h4 + 3]}; }
    __syncthreads();
}

__device__ __forceinline__ void phase0(const Params& P, LAS unsigned char* lds, int G, int bid) {
    unsigned char* ws = P.ws; const int tid = tid_opaque();
    const int NT_TOTAL = 2 * 512 + 2 * 256 + 2 * 64 + 2 * 256 + 4 * 1024 + 4 * 1024;
#define TJOB_DECODE(j, u4_) do { int t = (u4_) * 4; \
        if (t < 1024) { const int e = t / 512; t %= 512; j.W = P.w_in + (size_t)e * 1024 * 2048; j.WT = (bf16_t*)(ws + WS_WIN) + (size_t)e * 2048 * 1024; j.K = 1024; j.N = 2048; } \
        else if ((t -= 1024) < 512) { const int e = t / 256; t %= 256; j.W = P.w_out + (size_t)e * 1024 * 1024; j.WT = (bf16_t*)(ws + WS_WOUT) + (size_t)e * 1024 * 1024; j.K = 1024; j.N = 1024; } \
        else if ((t -= 512) < 128) { const int e = t / 64; t %= 64; j.W = P.w_glu + (size_t)e * 512 * 512; j.WT = (bf16_t*)(ws + WS_WGLU) + (size_t)e * 512 * 512; j.K = 512; j.N = 512; } \
        else if ((t -= 128) < 512) { const int e = t / 256; t %= 256; j.W = P.w_f + (size_t)e * 1024 * 1024; j.WT = (bf16_t*)(ws + WS_WF) + (size_t)e * 1024 * 1024; j.K = 1024; j.N = 1024; } \
        else if ((t -= 512) < 4096) { const int e = t / 1024; t %= 1024; j.W = P.w_ff1 + (size_t)e * 1024 * 4096; j.WT = (bf16_t*)P.out + (size_t)e * 4096 * 1024; j.K = 1024; j.N = 4096; } \
        else { t -= 4096; const int e = t / 1024; t %= 1024; j.W = P.w_ff2 + (size_t)e * 4096 * 1024; j.WT = (bf16_t*)P.out + (size_t)4 * 4096 * 1024 + (size_t)e * 1024 * 4096; j.K = 4096; j.N = 1024; } \
        j.t = t; } while (0)
    { f32x4 va[4], vb[4]; TJob cur; cur.W = nullptr; cur.WT = nullptr; cur.K = 0; cur.N = 64; cur.t = 0;
      int u4 = bid;
      if (u4 < NT_TOTAL / 4) { TJOB_DECODE(cur, u4); tjob_load(cur, tid, va, vb); }
      while (u4 < NT_TOTAL / 4) {
          f32x4 wa[4], wb[4];
#pragma unroll
          for (int q = 0; q < 4; ++q) { wa[q] = va[q]; wb[q] = vb[q]; }
          const TJob now = cur; const int nu = u4 + G;
          if (nu < NT_TOTAL / 4) { TJOB_DECODE(cur, nu); tjob_load(cur, tid, va, vb); }
          tjob_store(lds, now, tid, wa, wb);
          u4 = nu;
      } }
#undef TJOB_DECODE
    mod_stage(P, lds);
    for (int u = bid; u < 768; u += G) mod_unit(P, lds, (float*)(ws + WS_MOD), u);
    for (int u = bid; u < 256; u += G) ktab_unit(P, lds, (float*)(ws + WS_KTAB), (float*)(ws + WS_BBAR), (float*)(ws + WS_APOW), u);
    const size_t gtid = (size_t)bid * NTHR + tid, gn = (size_t)G * NTHR;
    { bf16_t* T = (bf16_t*)(ws + WS_CDSD);
      for (size_t i = gtid; i < (size_t)1024 * 1024 / 2; i += gn) { const int row = (int)(i >> 9), d0 = (int)(i & 511) * 2; const bool isSin = row >= 513; const int m = isSin ? row - 512 : row; float v[2];
#pragma unroll
          for (int j = 0; j < 2; ++j) { const float ang = (float)((m * (d0 + j)) & 1023) * (6.283185307179586f / 1024.f); v[j] = isSin ? sinf(ang) : cosf(ang); }
          *(unsigned*)(T + (size_t)row * 1024 + d0) = cvt_pk_bf16(v[0], v[1]); } }
    { bf16_t* T = (bf16_t*)(ws + WS_DA);
      for (size_t i = gtid; i < (size_t)256 * 256; i += gn) { const int row = (int)(i >> 8), col = (int)(i & 255); const int c = row >> 7, j = (row >> 6) & 1, k1 = row & 63, j2 = col >> 7, c2 = (col >> 6) & 1, t1 = col & 63;
          const float ang = (float)((k1 * t1) & 63) * (6.283185307179586f / 64.f); float v = 0.f;
          if (j == j2) v = (c == 0) ? (c2 == 0 ? cosf(ang) : -sinf(ang)) : (c2 == 0 ? -sinf(ang) : -cosf(ang));
          T[i] = f2bf(v); } }
    { bf16_t* T = (bf16_t*)(ws + WS_DC);
      for (size_t i = gtid; i < (size_t)256 * 512; i += gn) { const int row = (int)(i >> 9), col = (int)(i & 511); const int jj = row >> 6, k2 = row & 63, jj2 = col >> 7, c = (col >> 6) & 1, j = (col >> 5) & 1, tp = col & 31, t2 = 2 * tp + j;
          const float ang = (float)((k2 * t2) & 63) * (6.283185307179586f / 64.f); float v = 0.f;
          if (jj == jj2) v = c == 0 ? cosf(ang) : sinf(ang);
          T[i] = f2bf(v); } }
    { bf16_t* T = (bf16_t*)(ws + WS_AL256);
      for (size_t i = gtid; i < (size_t)256 * 512 / 2; i += gn) { const int k = (int)(i >> 8), c0 = (int)(i & 255) * 2; float v[2];
#pragma unroll
          for (int j = 0; j < 2; ++j) { const int cc = c0 + j, t = cc & 255; const float ang = (float)((k * t) & 255) * (6.283185307179586f / 256.f); v[j] = cc < 256 ? cosf(ang) : -sinf(ang); }
          *(unsigned*)(T + (size_t)k * 512 + c0) = cvt_pk_bf16(v[0], v[1]); } }
}

struct RowArgs {
    const float* hin_lat; const float* hin_ctx; float* hout_lat; float* hout_ctx;
    const bf16_t* R; const float* modA; int gate_off; const float* gainA;
    bf16_t* A; const float* modB; int shift_off, scale_off; const float* gainB;
    int nrows; int perm; const float* part; const bf16_t* hin_bf; bf16_t* hout_bf;
};
template <int RP, bool HINBF, bool HOUTBF> __device__ __forceinline__ void rows_seq(const RowArgs& a, int row0, int n, int bi, int lane) {
    const bool lat = row0 < TL;
    const float* hin = lat ? a.hin_lat + (size_t)row0 * D : a.hin_ctx + (size_t)(row0 - TL) * D;
    float* hout = lat ? a.hout_lat + (size_t)row0 * D : a.hout_ctx + (size_t)(row0 - TL) * D;
    const bf16_t* hinb = a.hin_bf + (size_t)row0 * D; bf16_t* houtb = a.hout_bf + (size_t)row0 * D;
    const bool hasR = a.R != nullptr, hasA = a.A != nullptr;
    const bf16_t* Rp = a.R + (size_t)row0 * D;
    f32x4 gg[4], gs[4], sh[4];
#pragma unroll
    for (int q = 0; q < 4; ++q) { const int col = 4 * lane + 256 * q;
        if (hasR) gg[q] = *(const f32x4*)(a.modA + (size_t)bi * 6144 + a.gate_off + col) * *(const f32x4*)(a.gainA + col);
        if (hasA) { gs[q] = *(const f32x4*)(a.gainB + col) * (*(const f32x4*)(a.modB + (size_t)bi * 6144 + a.scale_off + col) + 1.f); sh[q] = *(const f32x4*)(a.modB + (size_t)bi * 6144 + a.shift_off + col); } }
    f32x4 nh[RP][4]; u32x2 nhb[RP][4]; u32x2 nr[RP][4];
#define ROW_LOAD(i0) do { _Pragma("unroll") for (int r = 0; r < RP; ++r) _Pragma("unroll") for (int q = 0; q < 4; ++q) { \
        if (HINBF) nhb[r][q] = __builtin_nontemporal_load((const u32x2*)(hinb + (size_t)((i0) + r) * D + 4 * lane + 256 * q)); else nh[r][q] = __builtin_nontemporal_load((const f32x4*)(hin + (size_t)((i0) + r) * D + 4 * lane + 256 * q)); \
        if (hasR && lat) nr[r][q] = __builtin_nontemporal_load((const u32x2*)(Rp + (size_t)((i0) + r) * D + 4 * lane + 256 * q)); } } while (0)
    ROW_LOAD(0);
    for (int i = 0; i < n; i += RP) {
        f32x4 hv[RP][4]; u32x2 rw[RP][4];
#pragma unroll
        for (int r = 0; r < RP; ++r)
#pragma unroll
            for (int q = 0; q < 4; ++q) { if (HINBF) { hv[r][q][0] = bflo(nhb[r][q][0]); hv[r][q][1] = bfhi(nhb[r][q][0]); hv[r][q][2] = bflo(nhb[r][q][1]); hv[r][q][3] = bfhi(nhb[r][q][1]); } else hv[r][q] = nh[r][q]; rw[r][q] = nr[r][q]; }
        if (i + RP < n) ROW_LOAD(i + RP);
#pragma unroll
        for (int r = 0; r < RP; ++r) {
            if (hasR) {
                f32x4 rv[4]; float ss = 0.f;
#pragma unroll
                for (int q = 0; q < 4; ++q) {
                    if (lat) { rv[q][0] = bflo(rw[r][q][0]); rv[q][1] = bfhi(rw[r][q][0]); rv[q][2] = bflo(rw[r][q][1]); rv[q][3] = bfhi(rw[r][q][1]); }
                    else { const float* pp = a.part + (size_t)(row0 - TL + i + r) * 1024 + 4 * lane + 256 * q;
                        rv[q] = *(const f32x4*)pp + *(const f32x4*)(pp + (size_t)2048 * 1024) + *(const f32x4*)(pp + (size_t)2 * 2048 * 1024) + *(const f32x4*)(pp + (size_t)3 * 2048 * 1024); }
                    ss += rv[q][0] * rv[q][0] + rv[q][1] * rv[q][1] + rv[q][2] * rv[q][2] + rv[q][3] * rv[q][3]; }
                ss = wave_sum(ss); const float rinv = rsqrtf(ss * (1.f / 1024.f) + 1e-6f);
#pragma unroll
                for (int q = 0; q < 4; ++q) hv[r][q] += gg[q] * (rv[q] * rinv);
            }
            if (HOUTBF) {
#pragma unroll
                for (int q = 0; q < 4; ++q) { u32x2 o; o[0] = cvt_pk_bf16(hv[r][q][0], hv[r][q][1]); o[1] = cvt_pk_bf16(hv[r][q][2], hv[r][q][3]); __builtin_nontemporal_store(o, (u32x2*)(houtb + (size_t)(i + r) * D + 4 * lane + 256 * q)); }
            } else if (hasR) {
#pragma unroll
                for (int q = 0; q < 4; ++q) __builtin_nontemporal_store(hv[r][q], (f32x4*)(hout + (size_t)(i + r) * D + 4 * lane + 256 * q));
            }
            if (hasA) {
                float ss = 0.f;
#pragma unroll
                for (int q = 0; q < 4; ++q) ss += hv[r][q][0] * hv[r][q][0] + hv[r][q][1] * hv[r][q][1] + hv[r][q][2] * hv[r][q][2] + hv[r][q][3] * hv[r][q][3];
                ss = wave_sum(ss); const float rinv = rsqrtf(ss * (1.f / 1024.f) + 1e-6f);
#pragma unroll
                for (int q = 0; q < 4; ++q) { const f32x4 y = (hv[r][q] * rinv) * gs[q] + sh[q];
                    u32x2 o; o[0] = cvt_pk_bf16(y[0], y[1]); o[1] = cvt_pk_bf16(y[2], y[3]);
                    const int rr = row0 + i + r; const size_t arow = (lat && a.perm) ? (size_t)((rr & ~4095) | ((rr & 63) << 6) | ((rr >> 6) & 63)) : (size_t)rr;
                    *(u32x2*)(a.A + arow * D + 4 * lane + 256 * q) = o; }
            }
        }
    }
#undef ROW_LOAD
}
template <int MODE> __device__ __forceinline__ void row_phase(const RowArgs& a, int G, int bid) {
    const int tid = tid_opaque(), lane = tid & 63, wave = tid >> 6; const int gw = bid * 8 + wave, nw = G * 8;
    for (int c = gw; c < TL / 16; c += nw) rows_seq<2, (MODE >= 2), (MODE == 1 || MODE == 2)>(a, c * 16, 16, (c * 16) >> 12, lane);
    if (a.nrows > TL) for (int r = gw; r < TC; r += nw) rows_seq<1, false, false>(a, TL + r, 1, 8, lane);
}

__device__ __forceinline__ void build_s5(const Params& P, int e, int G, int bid) {
    unsigned char* ws = P.ws; const float* KT = (const float*)(ws + WS_KTAB); const float* BB = (const float*)(ws + WS_BBAR);
    bf16_t* MG = (bf16_t*)(ws + WS_BIG + BG_MG); bf16_t* WST = (bf16_t*)(ws + WS_BIG + BG_WST); const float* AP = (const float*)(ws + WS_APOW);
    const size_t gtid = (size_t)bid * NTHR + tid_opaque(), gn = (size_t)G * NTHR;
#pragma unroll 4
    for (size_t it = gtid; it < (size_t)32 * 1024 * 128; it += gn) {
        const int k8 = (int)(it & 127), n = (int)((it >> 7) & 1023), g = (int)(it >> 17);
        const int i = n >> 4, ho = n & 15, j = k8 >> 1, hi0 = (k8 & 1) * 8;
        const int dir = i >= j ? 0 : 1, l = i >= j ? i - j : j - i; const bool dg = i == j;
        const float* src = KT + ((size_t)((e * 2 + dir) * 32 + g) * 64 + l) * 256 + ho * 16 + hi0;
        const float* s1 = KT + ((size_t)((e * 2 + 1) * 32 + g) * 64) * 256 + ho * 16 + hi0;
        const f32x4 x0 = *(const f32x4*)src, x1 = *(const f32x4*)(src + 4);
        f32x4 y0 = {0.f, 0.f, 0.f, 0.f}, y1 = {0.f, 0.f, 0.f, 0.f}; float dv = 0.f;
        if (dg) { y0 = *(const f32x4*)s1; y1 = *(const f32x4*)(s1 + 4); dv = P.s5_d[e * 512 + g * 16 + ho]; }
        f32x4 v0 = x0 + y0, v1 = x1 + y1;
        if (dg) { if (ho < 8) { if (hi0 == 0) v0[ho & 3] += (ho < 4) ? dv : 0.f, v1[ho & 3] += (ho >= 4) ? dv : 0.f; } else { if (hi0 == 8) v0[ho & 3] += (ho < 12) ? dv : 0.f, v1[ho & 3] += (ho >= 12) ? dv : 0.f; } }
        *(u32x4*)(MG + ((size_t)(g * 1024 + n)) * ULD + k8 * 8) = pack8(v0, v1);
    }
#pragma unroll 2
    for (size_t it = gtid; it < (size_t)32 * 1024 * 32; it += gn) {
        const int k8 = 128 + (int)(it & 31), n = (int)((it >> 5) & 1023), g = (int)(it >> 15);
        const int i = n >> 4, ho = n & 15; float v[8];
        { const int kk0 = (k8 - 128) * 8, dir = kk0 >> 7, p0 = (kk0 & 127) >> 1; const int pw = dir == 0 ? (i + 1) : (64 - i);
            const int gi = (e * 2 + dir) * 32 + g;
            const f32x4 a01 = *(const f32x4*)(AP + ((size_t)(gi * 65 + pw) * 64 + p0) * 2), a23 = *(const f32x4*)(AP + ((size_t)(gi * 65 + pw) * 64 + p0) * 2 + 4);
            const f32x4 cr = *(const f32x4*)(P.c_re + (size_t)(gi * 16 + ho) * 64 + p0), ci = *(const f32x4*)(P.c_im + (size_t)(gi * 16 + ho) * 64 + p0);
            v[0] = cr[0] * a01[0] - ci[0] * a01[1]; v[1] = -(cr[0] * a01[1] + ci[0] * a01[0]);
            v[2] = cr[1] * a01[2] - ci[1] * a01[3]; v[3] = -(cr[1] * a01[3] + ci[1] * a01[2]);
            v[4] = cr[2] * a23[0] - ci[2] * a23[1]; v[5] = -(cr[2] * a23[1] + ci[2] * a23[0]);
            v[6] = cr[3] * a23[2] - ci[3] * a23[3]; v[7] = -(cr[3] * a23[3] + ci[3] * a23[2]); }
        u32x4 o; o[0] = cvt_pk_bf16(v[0], v[1]); o[1] = cvt_pk_bf16(v[2], v[3]); o[2] = cvt_pk_bf16(v[4], v[5]); o[3] = cvt_pk_bf16(v[6], v[7]);
        *(u32x4*)(MG + ((size_t)(g * 1024 + n)) * ULD + k8 * 8) = o;
    }
#pragma unroll 4
    for (size_t it = gtid; it < (size_t)32 * 256 * 128; it += gn) {
        const int k8 = (int)(it & 127), n = (int)((it >> 7) & 255), g = (int)(it >> 15);
        const int dir = n >> 7, p = (n & 127) >> 1, c = n & 1, j = k8 >> 1, hi0 = (k8 & 1) * 8; const int gi = (e * 2 + dir) * 32 + g;
        const f32x2 aa = *(const f32x2*)(AP + ((size_t)(gi * 65 + (dir == 0 ? 63 - j : j)) * 64 + p) * 2); const float ar = aa[0], ai = aa[1];
        const float* bb = BB + ((size_t)gi * 1024 + p * 16 + hi0) * 2; float v[8];
#pragma unroll
        for (int q = 0; q < 8; ++q) { const float br = bb[2 * q], bi = bb[2 * q + 1]; v[q] = c == 0 ? (ar * br - ai * bi) : (ar * bi + ai * br); }
        u32x4 o; o[0] = cvt_pk_bf16(v[0], v[1]); o[1] = cvt_pk_bf16(v[2], v[3]); o[2] = cvt_pk_bf16(v[4], v[5]); o[3] = cvt_pk_bf16(v[6], v[7]);
        *(u32x4*)(WST + ((size_t)(g * 256 + n)) * 1024 + k8 * 8) = o;
    }
}

__device__ __forceinline__ void carry_phase(const Params& P, int e, int G, int bid) {
    unsigned char* ws = P.ws; bf16_t* U = (bf16_t*)(ws + WS_BIG + BG_U); const float* SL = (const float*)(ws + WS_BIG + BG_SLOC); const float* AP = (const float*)(ws + WS_APOW);
    const int tid = tid_opaque(), lane = tid & 63, wave = tid >> 6;
    for (int wt = wave * G + bid; wt < 512; wt += 8 * G) {
        const int dir = wt & 1, g = (wt >> 1) & 31, b = wt >> 6, p = lane; const int gi = (e * 2 + dir) * 32 + g;
        const f32x2 aa = *(const f32x2*)(AP + ((size_t)(gi * 65 + 64) * 64 + p) * 2); const float ar = aa[0], ai = aa[1];
        float sr = 0.f, si = 0.f;
        for (int s17 = 0; s17 < 4; ++s17) {
            f32x2 sl[17];
#pragma unroll
            for (int q = 0; q < 17; ++q) { const int step = s17 * 17 + q; const int row = step < 4 ? 512 + 4 * b + (dir ? 3 - step : step) : 64 * b + (dir ? 63 - (step - 4) : step - 4);
                sl[q] = *(const f32x2*)(SL + ((size_t)(g * UROWS + row) * 256 + dir * 128 + 2 * p)); }
#pragma unroll
            for (int q = 0; q < 17; ++q) { const int step = s17 * 17 + q; const int row = step < 4 ? 512 + 4 * b + (dir ? 3 - step : step) : 64 * b + (dir ? 63 - (step - 4) : step - 4);
                *(unsigned*)(U + ((size_t)(g * UROWS + row) * ULD + 1024 + dir * 128 + 2 * p)) = cvt_pk_bf16(sr, si);
                const float nr = ar * sr - ai * si + sl[q][0], ni = ar * si + ai * sr + sl[q][1]; sr = nr; si = ni; }
        }
    }
}

template <int NB> struct NaS { f32x4 v[2][NB]; };
__device__ __forceinline__ void na_unit_dummy() {}
__device__ __forceinline__ void na_phase(const Params& P, LAS unsigned char* lds, int e, bool ctx_out, int G, int bid) {
    unsigned char* ws = P.ws; const bf16_t* QK = (const bf16_t*)(ws + WS_BIG + BG_QKV); const bf16_t* VT = QK + (size_t)TT * 1024; bf16_t* MO = (bf16_t*)(ws + WS_ABUF);
    const float* rpb = P.rpb + (size_t)e * 8 * 15 * 31;
    const int tid = tid_opaque(), lane = tid & 63, wave = tid >> 6, hs = wave >> 2, w4 = wave & 3, lq = lane & 15, lg = lane >> 4;
    constexpr int KBUF = 2 * 64 * 72 * 2;
    constexpr int TILE_B = 2 * KBUF;
    constexpr int RPB_OFF = 2 * TILE_B;
    LAS float* rpbs = (LAS float*)(lds + RPB_OFF);
    for (int i = tid; i < 8 * 15 * 31; i += NTHR) rpbs[i] = rpb[i] * 1.4426950408889634f;
#define KKEY(i) ((tid >> 4) + 32 * (i))
#define KHSL(i) ((tid >> 3) & 1)
#define KD0(i)  ((tid & 7) * 8)
#define VHSL(i) (i)
#define VDV(i)  ((tid >> 3) & 63)
#define VK8(i)  (tid & 7)
    const int koff = min(max(16 * w4 - 8, 0), 32);
    const int qc = 16 * w4 + lq, c0 = min(max(qc - 8, 0), 48);
    const int nlu = (1024 - bid + G - 1) / G, vb = (bid + G - 32) % G, ncu = (ctx_out && vb < 64) ? (64 - vb + G - 1) / G : 0;
    for (int it = 0; it < nlu + ncu; ++it) {
        const int u = it < nlu ? bid + it * G : 1024 + vb + (it - nlu) * G;
        int b, hp, qtokA, qtokB, r = 0, ra0 = 0, dlt = 0, npair; const bool islat = u < 1024;
        if (islat) { b = u >> 7; r = ((u >> 2) & 31) * 2; hp = u & 3; qtokA = b * 4096 + r * 64; qtokB = qtokA + 64; ra0 = min(max(r - 4, 0), 56); dlt = min(max(r - 3, 0), 56) - ra0; npair = 7; }
        else { const int v = u - 1024; b = v >> 3; const int qb2 = (v >> 2) & 1; hp = v & 3; qtokA = TL + b * 256 + qb2 * 128; qtokB = qtokA + 64; npair = 2; }
        const int head = 2 * hp + hs;
        bf16x8 qf[2][2];
        { const bf16_t* qpA = QK + (size_t)(qtokA + 16 * w4 + lq) * 1024 + head * 64 + 8 * lg; const bf16_t* qpB = QK + (size_t)(qtokB + 16 * w4 + lq) * 1024 + head * 64 + 8 * lg;
          qf[0][0] = *(const bf16x8*)qpA; qf[0][1] = *(const bf16x8*)(qpA + 32); qf[1][0] = *(const bf16x8*)qpB; qf[1][1] = *(const bf16x8*)(qpB + 32); }
        f32x4 O[2][4];
#pragma unroll
        for (int g2 = 0; g2 < 2; ++g2)
#pragma unroll
            for (int i = 0; i < 4; ++i) O[g2][i] = (f32x4){0.f, 0.f, 0.f, 0.f};
        float mrun[2] = {-1e30f, -1e30f}, lrun[2] = {0.f, 0.f};
        u32x4 kreg[2][2], vreg[2][2];
#define NA_KTOK(t) (islat ? ((t) < 10 ? b * 4096 + min(ra0 + (t), 63) * 64 : TL + b * 256 + ((t) - 10) * 64) : TL + b * 256 + (t) * 64)
#define NA_LOAD(pr) do { _Pragma("unroll") for (int s_ = 0; s_ < 2; ++s_) { const int _kt = NA_KTOK(2 * (pr) + s_); _Pragma("unroll") for (int i = 0; i < 2; ++i) { \
            kreg[s_][i] = *(const u32x4*)(QK + (size_t)(_kt + KKEY(i)) * 1024 + 512 + (2 * hp + KHSL(i)) * 64 + KD0(i)); \
            vreg[s_][i] = *(const u32x4*)(VT + (size_t)((2 * hp + VHSL(i)) * 64 + VDV(i)) * TT + _kt + VK8(i) * 8); } } } while (0)
#define NA_WRITE() do { _Pragma("unroll") for (int s_ = 0; s_ < 2; ++s_) _Pragma("unroll") for (int i = 0; i < 2; ++i) { \
            *(LAS u32x4*)(lds + s_ * TILE_B + ((KHSL(i) * 64 + KKEY(i)) * 72 + KD0(i)) * 2) = kreg[s_][i]; \
            *(LAS u32x4*)(lds + s_ * TILE_B + KBUF + ((VHSL(i) * 64 + VDV(i)) * 72 + VK8(i) * 8) * 2) = vreg[s_][i]; } } while (0)
        NA_LOAD(0);
        for (int pr = 0; pr < npair; ++pr) {
            __syncthreads();
            NA_WRITE();
            __syncthreads();
            if (pr + 1 < npair) NA_LOAD(pr + 1);
            if (islat && pr < 5) {
                const int t0 = 2 * pr;
                bool actg[2][2];
#pragma unroll
                for (int g2 = 0; g2 < 2; ++g2) { const int lo = g2 ? dlt : 0, hi = lo + 7; actg[g2][0] = (t0 >= lo) && (t0 <= hi); actg[g2][1] = (t0 + 1 >= lo) && (t0 + 1 <= hi); }
                f32x4 S[2][2][2];
#pragma unroll
                for (int s_ = 0; s_ < 2; ++s_)
#pragma unroll
                    for (int kb = 0; kb < 2; ++kb) {
                        const LAS unsigned char* ka = lds + s_ * TILE_B + ((hs * 64 + koff + 16 * kb + lq) * 72 + 8 * lg) * 2;
                        const bf16x8 a0 = *(const LAS bf16x8*)ka, a1 = *(const LAS bf16x8*)(ka + 64);
#pragma unroll
                        for (int g2 = 0; g2 < 2; ++g2) {
                            if (actg[g2][s_]) { const int dr = (ra0 + t0 + s_) - (r + g2) + 7; const LAS float* bp = rpbs + (head * 15 + min(max(dr, 0), 14)) * 31;
                                f32x4 acc = (f32x4){0.f, 0.f, 0.f, 0.f};
                                acc = __builtin_amdgcn_mfma_f32_16x16x32_bf16(a0, qf[g2][0], acc, 0, 0, 0);
                                acc = __builtin_amdgcn_mfma_f32_16x16x32_bf16(a1, qf[g2][1], acc, 0, 0, 0);
#pragma unroll
                                for (int v = 0; v < 4; ++v) { const int kc = koff + 16 * kb + 4 * lg + v; const bool ok = (unsigned)(kc - c0) < 16u; acc[v] = ok ? acc[v] + bp[kc - qc + 15] : -1e30f; }
                                S[g2][s_][kb] = acc;
                            } else S[g2][s_][kb] = (f32x4){-1e30f, -1e30f, -1e30f, -1e30f};
                        } }
#pragma unroll
                for (int g2 = 0; g2 < 2; ++g2) {
                    if (actg[g2][0] || actg[g2][1]) {
                        float tmax = -1e30f;
#pragma unroll
                        for (int s_ = 0; s_ < 2; ++s_)
#pragma unroll
                            for (int kb = 0; kb < 2; ++kb)
#pragma unroll
                                for (int v = 0; v < 4; ++v) tmax = fmaxf(tmax, S[g2][s_][kb][v]);
                        tmax = fmaxf(tmax, __shfl_xor(tmax, 16)); tmax = fmaxf(tmax, __shfl_xor(tmax, 32));
                        const float mnew = fmaxf(mrun[g2], tmax), alpha = __builtin_amdgcn_exp2f(mrun[g2] - mnew); mrun[g2] = mnew;
                        float lsum = 0.f;
#pragma unroll
                        for (int s_ = 0; s_ < 2; ++s_)
#pragma unroll
                            for (int kb = 0; kb < 2; ++kb)
#pragma unroll
                                for (int v = 0; v < 4; ++v) { const float pv = __builtin_amdgcn_exp2f(S[g2][s_][kb][v] - mnew); S[g2][s_][kb][v] = pv; lsum += pv; }
                        lrun[g2] = lrun[g2] * alpha + lsum;
#pragma unroll
                        for (int i = 0; i < 4; ++i) O[g2][i] *= alpha;
#pragma unroll
                        for (int s_ = 0; s_ < 2; ++s_) { const u32x4 pk = pack8(S[g2][s_][0], S[g2][s_][1]); const bf16x8 pbv = __builtin_bit_cast(bf16x8, pk);
#pragma unroll
                            for (int dvb = 0; dvb < 4; ++dvb) { const LAS unsigned char* va = lds + s_ * TILE_B + KBUF + ((hs * 64 + 16 * dvb + lq) * 72 + koff + 4 * lg) * 2;
                                const u32x2 x0 = *(const LAS u32x2*)va, x1 = *(const LAS u32x2*)(va + 32); u32x4 av; av[0] = x0[0]; av[1] = x0[1]; av[2] = x1[0]; av[3] = x1[1];
                                O[g2][dvb] = __builtin_amdgcn_mfma_f32_16x16x32_bf16(__builtin_bit_cast(bf16x8, av), pbv, O[g2][dvb], 0, 0, 0); } }
                    }
                }
            } else {
#pragma unroll
                for (int s_ = 0; s_ < 2; ++s_) {
                    f32x4 S[2][4];
#pragma unroll
                    for (int kb = 0; kb < 4; ++kb) {
                        const LAS unsigned char* ka = lds + s_ * TILE_B + ((hs * 64 + 16 * kb + lq) * 72 + 8 * lg) * 2;
                        const bf16x8 a0 = *(const LAS bf16x8*)ka, a1 = *(const LAS bf16x8*)(ka + 64);
#pragma unroll
                        for (int g2 = 0; g2 < 2; ++g2) { S[g2][kb] = (f32x4){0.f, 0.f, 0.f, 0.f};
                            S[g2][kb] = __builtin_amdgcn_mfma_f32_16x16x32_bf16(a0, qf[g2][0], S[g2][kb], 0, 0, 0);
                            S[g2][kb] = __builtin_amdgcn_mfma_f32_16x16x32_bf16(a1, qf[g2][1], S[g2][kb], 0, 0, 0); } }
#pragma unroll
                    for (int g2 = 0; g2 < 2; ++g2) {
                        float tmax = -1e30f;
#pragma unroll
                        for (int kb = 0; kb < 4; ++kb)
#pragma unroll
                            for (int v = 0; v < 4; ++v) tmax = fmaxf(tmax, S[g2][kb][v]);
                        tmax = fmaxf(tmax, __shfl_xor(tmax, 16)); tmax = fmaxf(tmax, __shfl_xor(tmax, 32));
                        const float mnew = fmaxf(mrun[g2], tmax), alpha = __builtin_amdgcn_exp2f(mrun[g2] - mnew); mrun[g2] = mnew;
                        float lsum = 0.f;
#pragma unroll
                        for (int kb = 0; kb < 4; ++kb)
#pragma unroll
                            for (int v = 0; v < 4; ++v) { const float pv = __builtin_amdgcn_exp2f(S[g2][kb][v] - mnew); S[g2][kb][v] = pv; lsum += pv; }
                        lrun[g2] = lrun[g2] * alpha + lsum;
#pragma unroll
                        for (int i = 0; i < 4; ++i) O[g2][i] *= alpha;
#pragma unroll
                        for (int kk = 0; kk < 2; ++kk) { const u32x4 pk = pack8(S[g2][2 * kk], S[g2][2 * kk + 1]); const bf16x8 pbv = __builtin_bit_cast(bf16x8, pk);
#pragma unroll
                            for (int dvb = 0; dvb < 4; ++dvb) { const LAS unsigned char* va = lds + s_ * TILE_B + KBUF + ((hs * 64 + 16 * dvb + lq) * 72 + 32 * kk + 4 * lg) * 2;
                                const u32x2 x0 = *(const LAS u32x2*)va, x1 = *(const LAS u32x2*)(va + 32); u32x4 av; av[0] = x0[0]; av[1] = x0[1]; av[2] = x1[0]; av[3] = x1[1];
                                O[g2][dvb] = __builtin_amdgcn_mfma_f32_16x16x32_bf16(__builtin_bit_cast(bf16x8, av), pbv, O[g2][dvb], 0, 0, 0); } }
                    }
                }
            }
        }
#undef NA_KTOK
#undef NA_LOAD
#undef NA_WRITE
#pragma unroll
        for (int g2 = 0; g2 < 2; ++g2) {
            float lr = lrun[g2]; lr += __shfl_xor(lr, 16); lr += __shfl_xor(lr, 32);
            const float inv = 1.f / lr;
            bf16_t* op = MO + (size_t)((g2 ? qtokB : qtokA) + 16 * w4 + lq) * 1024 + 512 + head * 64 + 4 * lg;
#pragma unroll
            for (int dvb = 0; dvb < 4; ++dvb) { u32x2 o; o[0] = cvt_pk_bf16(O[g2][dvb][0] * inv, O[g2][dvb][1] * inv); o[1] = cvt_pk_bf16(O[g2][dvb][2] * inv, O[g2][dvb][3] * inv); *(u32x2*)(op + 16 * dvb) = o; }
        }
    }
    __syncthreads();
}

#define XB_TMO      128
#define XB_XCNT(j)  (256  + 64 * (j))
#define XB_XSUB(j)  (1280 + 64 * (j))
#define XB_XGEN(j)  (2304 + 64 * (j))
#define XB_TOP      3328
#define XB_TOPGEN   3392
#define XCD_BAR_WORDS 3456
#define XB_SPIN_CAP (1u << 18)
__device__ __forceinline__ unsigned xb_ld(unsigned* p)              { return __hip_atomic_load(p, __ATOMIC_RELAXED, __HIP_MEMORY_SCOPE_AGENT); }
__device__ __forceinline__ unsigned xb_add(unsigned* p, unsigned v) { return __hip_atomic_fetch_add(p, v, __ATOMIC_RELAXED, __HIP_MEMORY_SCOPE_AGENT); }
__device__ __forceinline__ unsigned xb_xcc_id() { return (unsigned)__builtin_amdgcn_s_getreg((3 << 11) | 20) & 0xFu; }
#define XB_SPIN(cond, bar) do { unsigned _sp = 0; while (cond) { __builtin_amdgcn_s_sleep(1); \
    if ((++_sp & 255u) == 0u) { if (xb_ld(&(bar)[XB_TMO])) break; if (_sp > XB_SPIN_CAP) { atomicAdd(&(bar)[XB_TMO], 1u); break; } } } } while (0)
struct XcdBarrier { unsigned* bar; unsigned x; volatile LAS unsigned* st; };
__device__ __forceinline__ XcdBarrier xcd_barrier_post(unsigned* bar, volatile LAS unsigned* st) {
    XcdBarrier b; b.bar = bar; b.x = xb_xcc_id(); b.st = st;
    if (threadIdx.x == 0) (void)xb_add(&bar[XB_XCNT(b.x)], 1u);
    return b;
}
__device__ __forceinline__ void xcd_barrier_complete(unsigned* bar, unsigned x, unsigned& nloc, unsigned& nx) {
    const unsigned G = gridDim.x * gridDim.y * gridDim.z;
    unsigned sum, cnt, mine, sp = 0u;
    for (;;) {
        sum = 0u; cnt = 0u; mine = 0u;
#pragma unroll
        for (unsigned j = 0; j < 16; ++j) { const unsigned c = xb_ld(&bar[XB_XCNT(j)]); sum += c; cnt += (c > 0u) ? 1u : 0u; mine = (j == x) ? c : mine; }
        if (sum == G) break;
        __builtin_amdgcn_s_sleep(1);
        if ((++sp & 255u) == 0u) { if (xb_ld(&bar[XB_TMO])) break; if (sp > XB_SPIN_CAP) { atomicAdd(&bar[XB_TMO], 1u); break; } }
    }
    nloc = mine > 0u ? mine : 1u; nx = cnt > 0u ? cnt : 1u;
}
__device__ __attribute__((noinline)) void xcd_barrier_fn(unsigned* bar_, unsigned x_, unsigned stoff) {
    XcdBarrier b; b.bar = bar_; b.x = x_; b.st = (volatile LAS unsigned*)(unsigned long)stoff;
    asm volatile("s_waitcnt vmcnt(0)" ::: "memory");
    __syncthreads();
    if (threadIdx.x == 0) {
        unsigned* bar = b.bar;
        __builtin_amdgcn_s_waitcnt(0);
        unsigned nloc = b.st[0], nx = b.st[1];
        if (nloc == 0u) { xcd_barrier_complete(bar, b.x, nloc, nx); b.st[0] = nloc; b.st[1] = nx; }
        const unsigned old = xb_add(&bar[XB_XSUB(b.x)], 1u);
        const unsigned gen = old / nloc;
        if (old + 1u == (gen + 1u) * nloc) {
            __builtin_amdgcn_fence(__ATOMIC_RELEASE, "agent");
            asm volatile("s_waitcnt vmcnt(0)" ::: "memory");
            const unsigned og = xb_add(&bar[XB_TOP], 1u);
            const unsigned tg = og / nx;
            if (og + 1u == (tg + 1u) * nx) xb_add(&bar[XB_TOPGEN], 1u);
            else XB_SPIN(xb_ld(&bar[XB_TOPGEN]) == tg, bar);
            __builtin_amdgcn_fence(__ATOMIC_ACQUIRE, "agent");
            xb_add(&bar[XB_XGEN(b.x)], 1u);
            asm volatile("s_waitcnt vmcnt(0)" ::: "memory");
        } else {
            XB_SPIN(xb_ld(&bar[XB_XGEN(b.x)]) == gen, bar);
            __builtin_amdgcn_fence(__ATOMIC_ACQUIRE, "agent");
            asm volatile("s_waitcnt vmcnt(0)" ::: "memory");
        }
    }
    __syncthreads();
}


__device__ __forceinline__ const float* ldp(volatile LAS unsigned* q, int i) {
    const unsigned lo = __builtin_amdgcn_readfirstlane(q[2 * i]), hi = __builtin_amdgcn_readfirstlane(q[2 * i + 1]);
    return (const float*)(((unsigned long)hi << 32) | lo);
}
__device__ __forceinline__ Params load_params(LAS unsigned char* lds) {
    volatile LAS unsigned* q = (volatile LAS unsigned*)(lds + LDS_PARAM);
    Params P;
    P.x = ldp(q, 0); P.c = ldp(q, 1); P.ctx = ldp(q, 2); P.c_ctx = ldp(q, 3); P.w_mod = ldp(q, 4); P.b_mod = ldp(q, 5); P.norm_g = ldp(q, 6);
    P.w_in = ldp(q, 7); P.w_out = ldp(q, 8); P.lam_re = ldp(q, 9); P.lam_im = ldp(q, 10); P.log_dt = ldp(q, 11); P.b_re = ldp(q, 12); P.b_im = ldp(q, 13);
    P.c_re = ldp(q, 14); P.c_im = ldp(q, 15); P.s5_d = ldp(q, 16); P.w_glu = ldp(q, 17); P.rpb = ldp(q, 18); P.w_f = ldp(q, 19); P.w_ff1 = ldp(q, 20); P.w_ff2 = ldp(q, 21);
    P.out = (float*)ldp(q, 22); P.ws = (unsigned char*)ldp(q, 23);
    return P;
}
__global__ void __launch_bounds__(NTHR, 2) mega(Params Pk) {
    extern __shared__ __attribute__((aligned(16))) unsigned char shm[];
    LAS unsigned char* lds = (LAS unsigned char*)shm;
    cg::grid_group grid = cg::this_grid();
    if (threadIdx.x == 0) { volatile LAS unsigned long* q = (volatile LAS unsigned long*)(lds + LDS_PARAM);
        q[0] = (unsigned long)Pk.x; q[1] = (unsigned long)Pk.c; q[2] = (unsigned long)Pk.ctx; q[3] = (unsigned long)Pk.c_ctx; q[4] = (unsigned long)Pk.w_mod; q[5] = (unsigned long)Pk.b_mod;
        q[6] = (unsigned long)Pk.norm_g; q[7] = (unsigned long)Pk.w_in; q[8] = (unsigned long)Pk.w_out; q[9] = (unsigned long)Pk.lam_re; q[10] = (unsigned long)Pk.lam_im; q[11] = (unsigned long)Pk.log_dt;
        q[12] = (unsigned long)Pk.b_re; q[13] = (unsigned long)Pk.b_im; q[14] = (unsigned long)Pk.c_re; q[15] = (unsigned long)Pk.c_im; q[16] = (unsigned long)Pk.s5_d; q[17] = (unsigned long)Pk.w_glu;
        q[18] = (unsigned long)Pk.rpb; q[19] = (unsigned long)Pk.w_f; q[20] = (unsigned long)Pk.w_ff1; q[21] = (unsigned long)Pk.w_ff2; q[22] = (unsigned long)Pk.out; q[23] = (unsigned long)Pk.ws; }
    { volatile LAS unsigned* st0 = (volatile LAS unsigned*)(lds + LDS_STAGE); if (threadIdx.x < 16) st0[threadIdx.x] = 0u; }
    __syncthreads();
    if (blockIdx.x == 0) { unsigned* bw = (unsigned*)(Pk.ws + WS_BAR); for (int i = threadIdx.x; i < XCD_BAR_WORDS; i += NTHR) bw[i] = 0u; }
#define PHASE_BEGIN { const Params P = load_params(lds); int G = gridDim.x, bid = blockIdx.x; asm volatile("" : "+s"(G), "+s"(bid)); unsigned char* ws = P.ws; \
        bf16_t* ABUF = (bf16_t*)(ws + WS_ABUF); float* SCTX = (float*)(ws + WS_SCTX); const float* MOD = (const float*)(ws + WS_MOD); (void)ABUF; (void)SCTX; (void)MOD; (void)G; (void)bid;
#define PHASE_END   xcd_barrier_fn((unsigned*)(ws + WS_BAR), xb_xcc_id(), (unsigned)LDS_STAGE); }
#define PHASE_END_CG grid.sync(); }
#define PHASE_END_LAST }

    PHASE_BEGIN DUP(8, phase0(P, lds, G, bid)); PHASE_END_CG
    { const Params P = load_params(lds); (void)xcd_barrier_post((unsigned*)(P.ws + WS_BAR), (volatile LAS unsigned*)(lds + LDS_STAGE)); }
    PHASE_BEGIN
        RowArgs a{}; a.hin_lat = P.x; a.hin_ctx = P.ctx; a.hout_lat = (float*)P.x; a.hout_ctx = (float*)P.ctx; a.R = nullptr; a.A = ABUF; a.modB = MOD; a.shift_off = 0; a.scale_off = 1024; a.gainB = P.norm_g; a.nrows = TT;
        row_phase<0>(a, G, bid);
    PHASE_END

    for (int L = 0; L < 4; ++L) {
        const bool upd_ctx = L < 2;
        const int MT = upd_ctx ? TT / 256 : TL / 256;
#define HB_  ((bf16_t*)(ws + WS_W1))
#define W1T_ ((const bf16_t*)P.out)
#define W2T_ ((const bf16_t*)P.out + (size_t)4 * 4096 * 1024)
#define MODL (MOD + (size_t)L * 9 * 6144)
#define NGL  (P.norm_g + (size_t)L * 4 * 1024)
#define BIGP (ws + WS_BIG)
#define U_   ((bf16_t*)(BIGP + BG_U))
#define QKV_ ((bf16_t*)(BIGP + BG_QKV))
#define GB_  ((bf16_t*)(BIGP + BG_G))
#define RBE_ ((bf16_t*)(BIGP + BG_R))
#define ZA_  ((bf16_t*)(BIGP + BO_ZA))
#define YC_  ((bf16_t*)(BIGP + BO_YC))
#define PQC_ ((bf16_t*)(BIGP + BO_PQC))
#define AODD_ ((bf16_t*)(BIGP + BO_YC))
#define RBO_ ((bf16_t*)(BIGP + BO_R))
        if ((L & 1) == 0) {
            const int e = L >> 1;
            PHASE_BEGIN
                { const int skip = (1088 % G) < G / 2 ? (1088 % G) : 0;
                  if (bid >= skip) DUP(16, build_s5(P, e, G - skip, bid - skip)); }
                Gemm g{ABUF, (const bf16_t*)(ws + WS_WIN) + (size_t)e * 2048 * 1024, 0, 0, 1024, 1024, TT / 256, 8, 1, 1024};
                Epi<M_WIN> E{0, U_, QKV_, nullptr, 0.f}; DUP(1, gemm_phase(lds, g, E, G, bid));
            PHASE_END
            PHASE_BEGIN
                Gemm g{U_, (const bf16_t*)(BIGP + BG_WST), (long)UROWS * ULD, 256L * 1024, ULD, 1024, 3, 1, 32, 1024};
                Epi<M_SLOC> E{0, BIGP + BG_SLOC, nullptr, nullptr, 0.f}; DUP(1, gemm_phase(lds, g, E, G, (bid + 96) % G));
                DUP(4, na_phase(P, lds, e, upd_ctx, G, bid));
            PHASE_END
            PHASE_BEGIN DUP(16, carry_phase(P, e, G, bid)); PHASE_END
            PHASE_BEGIN
                Gemm g{U_, (const bf16_t*)(BIGP + BG_MG), (long)UROWS * ULD, 1024L * ULD, ULD, ULD, upd_ctx ? 3 : 2, 4, 32, ULD};
                Epi<M_YG> E{upd_ctx ? UROWS : 512, GB_, nullptr, nullptr, 0.f}; DUP(1, gemm_phase(lds, g, E, G, bid));
            PHASE_END
            PHASE_BEGIN
                Gemm g{GB_, (const bf16_t*)(ws + WS_WGLU) + (size_t)e * 512 * 512, 0, 0, 512, 512, MT, 2, 1, 512};
                Epi<M_GLU> E{0, ABUF, nullptr, GB_, 0.f}; DUP(1, gemm_phase(lds, g, E, G, bid));
            PHASE_END
            PHASE_BEGIN
                Gemm g{ABUF, (const bf16_t*)(ws + WS_WOUT) + (size_t)e * 1024 * 1024, 0, 0, 1024, 1024, TL / 256, 4, 1, 1024};
                Epi<M_PLAIN> E{1024, RBE_, nullptr, nullptr, 0.f}; DUP(1, gemm_phase(lds, g, E, G, bid));
                if (upd_ctx) { Gemm g2{ABUF + (size_t)TL * 1024, (const bf16_t*)(ws + WS_WOUT) + (size_t)e * 1024 * 1024, 256, 256, 1024, 1024, 8, 4, 4, 256};
                    Epi<M_PART> E2{0, ws + WS_PART, nullptr, nullptr, 0.f}; DUP(1, gemm_phase(lds, g2, E2, G, bid)); }
            PHASE_END
        } else {
            const int o = L >> 1;
            PHASE_BEGIN
                Gemm g{(const bf16_t*)(ws + WS_CDSD), AODD_, 0, 0, 1024, 1024, 4, MT, 1, 1024};
                Epi<M_PQ> E{0, ZA_, PQC_, nullptr, 0.f}; DUP(1, gemm_phase(lds, g, E, G, bid));
            PHASE_END
            PHASE_BEGIN
                Gemm g{(const bf16_t*)(ws + WS_DA), ZA_, 0, 0, 256, 256, 1, 1024, 1, 256};
                Epi<M_FA> E{0, YC_, nullptr, nullptr, 0.f}; DUP(2, gemm_phase(lds, g, E, G, bid));
                if (upd_ctx) { Gemm g2{(const bf16_t*)(ws + WS_AL256), PQC_, 0, 512, 512, 4096, 1, 4, 8, 512};
                    Epi<M_POSC> E2{0, ABUF, nullptr, nullptr, 1.f / 512.f}; DUP(2, gemm_phase(lds, g2, E2, G, bid)); }
            PHASE_END
            PHASE_BEGIN
                Gemm g{(const bf16_t*)(ws + WS_DC), YC_, 0, 0, 512, 512, 1, 512, 1, 512};
                Epi<M_FC> E{0, ABUF, nullptr, nullptr, 1.f / 2048.f}; DUP(2, gemm_phase(lds, g, E, G, bid));
            PHASE_END
            PHASE_BEGIN
                Gemm g{ABUF, (const bf16_t*)(ws + WS_WF) + (size_t)o * 1024 * 1024, 0, 0, 1024, 1024, TL / 256, 4, 1, 1024};
                Epi<M_PLAIN> E{1024, RBO_, nullptr, nullptr, 0.f}; DUP(1, gemm_phase(lds, g, E, G, bid));
                if (upd_ctx) { Gemm g2{ABUF + (size_t)TL * 1024, (const bf16_t*)(ws + WS_WF) + (size_t)o * 1024 * 1024, 256, 256, 1024, 1024, 8, 4, 4, 256};
                    Epi<M_PART> E2{0, ws + WS_PART, nullptr, nullptr, 0.f}; DUP(1, gemm_phase(lds, g2, E2, G, bid)); }
            PHASE_END
        }
        PHASE_BEGIN
            RowArgs a{}; a.hin_lat = P.x; a.hin_ctx = L == 0 ? P.ctx : SCTX; a.hout_lat = nullptr; a.hout_ctx = SCTX; a.hin_bf = HB_; a.hout_bf = HB_; a.R = (L & 1) ? RBO_ : RBE_; a.modA = MODL; a.gate_off = 2048; a.gainA = NGL + 1024;
            a.A = ABUF; a.modB = MODL; a.shift_off = 3072; a.scale_off = 4096; a.gainB = NGL + 2048; a.nrows = MT * 256; a.part = (const float*)(ws + WS_PART);
            if (L == 0) row_phase<1>(a, G, bid); else row_phase<2>(a, G, bid);
        PHASE_END
        PHASE_BEGIN
            Gemm g{ABUF, W1T_ + (size_t)L * 4096 * 1024, 0, 0, 1024, 1024, MT, 16, 1, 1024};
            Epi<M_SQRELU> E{4096, ws + WS_BIG, nullptr, nullptr, 0.f}; DUP(1, gemm_phase(lds, g, E, G, bid));
        PHASE_END
        PHASE_BEGIN
            Gemm g{(const bf16_t*)(ws + WS_BIG), W2T_ + (size_t)L * 1024 * 4096, 0, 0, 4096, 4096, TL / 256, 4, 1, 4096, 1};
            Epi<M_PLAIN> E{1024, ABUF, nullptr, nullptr, 0.f}; DUP(1, gemm_phase(lds, g, E, G, bid));
            if (upd_ctx) { Gemm g2{(const bf16_t*)(ws + WS_BIG) + (size_t)TL * 4096, W2T_ + (size_t)L * 1024 * 4096, 1024, 1024, 4096, 4096, 8, 4, 4, 1024};
                Epi<M_PART> E2{0, ws + WS_PART, nullptr, nullptr, 0.f}; DUP(1, gemm_phase(lds, g2, E2, G, bid)); }
        PHASE_END
        PHASE_BEGIN
            RowArgs a{}; a.hin_lat = nullptr; a.hin_ctx = SCTX; a.hout_lat = P.out; a.hout_ctx = SCTX; a.hin_bf = HB_; a.hout_bf = HB_; a.R = ABUF; a.modA = MODL; a.gate_off = 5120; a.gainA = NGL + 3072; a.nrows = MT * 256; a.part = (const float*)(ws + WS_PART);
            if (L < 3) { a.A = ((L + 1) & 1) ? AODD_ : ABUF; a.modB = MOD + (size_t)(L + 1) * 9 * 6144; a.shift_off = 0; a.scale_off = 1024; a.gainB = P.norm_g + (size_t)(L + 1) * 4 * 1024; a.perm = ((L + 1) & 1); } else a.A = nullptr;
            if (L < 3) row_phase<2>(a, G, bid); else row_phase<3>(a, G, bid);
            if (L < 3) xcd_barrier_fn((unsigned*)(ws + WS_BAR), xb_xcc_id(), (unsigned)LDS_STAGE);
        PHASE_END_LAST
    }
}
constexpr int N_PHASES = 2 + 10 + 8 + 10 + 8;

extern "C" void kernel_launch(void* const* d_in, const int* in_sizes, int n_in, void* d_out, int out_size, void* d_ws, size_t ws_size, hipStream_t stream) {
    static int grid = 0;
    if (grid == 0) {
        if (n_in != 22 || ws_size < WS_END) { fprintf(stderr, "kernel_launch: unexpected n_in %d / ws_size %zu (need %zu)\n", n_in, ws_size, (size_t)WS_END); grid = -1; return; }
        int dev = 0, cus = 0, per_cu = 0;
        hipGetDevice(&dev); hipDeviceGetAttribute(&cus, hipDeviceAttributeMultiprocessorCount, dev);
        if (hipFuncSetAttribute((const void*)mega, hipFuncAttributeMaxDynamicSharedMemorySize, LDS_BYTES) != hipSuccess) { fprintf(stderr, "hipFuncSetAttribute failed\n"); grid = -1; return; }
        if (hipOccupancyMaxActiveBlocksPerMultiprocessor(&per_cu, (const void*)mega, NTHR, LDS_BYTES) != hipSuccess || per_cu < 1) { fprintf(stderr, "occupancy query: %d\n", per_cu); per_cu = 1; }
        (void)hipGetLastError();
        grid = cus * 1;
    }
    if (grid < 0) return;
    Params p{};
    const float** pp = (const float**)&p;
    for (int i = 0; i < 22; ++i) pp[i] = (const float*)d_in[i];
    p.out = (float*)d_out; p.ws = (unsigned char*)d_ws;
#if N_LAUNCH_MODE == 1
    void* args[] = {&p};
    hipError_t e = hipLaunchCooperativeKernel((const void*)mega, dim3(grid), dim3(NTHR), args, LDS_BYTES, stream);
    if (e != hipSuccess) fprintf(stderr, "cooperative launch failed: %s (grid %d)\n", hipGetErrorString(e), grid);
#else
    fprintf(stderr, "per-phase launch mode removed\n");
#endif
}
```
